# Optimizing an MI355X kernel written in HIP

```python
import math
import jax, jax.numpy as jnp
from jax import lax
import numpy as np

D_MODEL = 1024
BATCH = 32
SEQ = 256
DEPTH = 1
DEC_BATCH = 8
DEC_SEQ = 1024
PAST_LEN = 256

GRID_W = 64
ROPE_THETA = 10000.0
NORM_EPS = 1e-6
MLA_HEADS = 4
QK_NOPE = 128
QK_ROPE = 64
V_HEAD = 128
Q_LORA = 384
KV_LORA = 256
MLA_WIDTH = MLA_HEADS * V_HEAD
SSM_HEADS = 8
SSM_HEAD_DIM = 64
SSM_WIDTH = SSM_HEADS * SSM_HEAD_DIM
SSM_GROUPS = 2
D_STATE = 128
D_CONV = 3
CHUNK = 128
CONV_DIM = SSM_WIDTH + 2 * SSM_GROUPS * D_STATE
MIX_WIDTH = MLA_WIDTH + SSM_WIDTH
IN_WIDTH = Q_LORA + KV_LORA + QK_ROPE + SSM_WIDTH + CONV_DIM + 2 * SSM_HEADS
D_FF = -(-8 * D_MODEL // (3 * 256)) * 256
Q_BLOCK = 128

kernel_name = "hybrid_mla_ssd_prefix_dit_step"


def rms_norm(x, g):
    xf = x.astype(jnp.float32)
    y = xf * lax.rsqrt(jnp.mean(xf * xf, axis=-1, keepdims=True) + NORM_EPS)
    return (y * g.astype(jnp.float32)).astype(x.dtype)


def adaln(cond, w_mod, b_mod):
    m = jax.nn.silu(cond) @ w_mod + b_mod
    if m.ndim == 2:
        m = m[:, None, :]
    return jnp.split(m, 6, axis=-1)


def rope_2d(x, length):
    rows = length // GRID_W
    row = jnp.repeat(jnp.arange(rows), GRID_W)
    col = jnp.tile(jnp.arange(GRID_W), rows)
    half = QK_ROPE // 2
    quarter = half // 2
    inv_freq = ROPE_THETA ** (-jnp.arange(quarter, dtype=jnp.float32) / quarter)
    bshape = (1, length) + (1,) * (x.ndim - 3) + (quarter,)

    def rot(xa, pos):
        ang = pos.astype(jnp.float32)[:, None] * inv_freq[None, :]
        cos = jnp.cos(ang).reshape(bshape)
        sin = jnp.sin(ang).reshape(bshape)
        xa = xa.astype(jnp.float32)
        x1, x2 = xa[..., :quarter], xa[..., quarter:]
        return jnp.concatenate([x1 * cos - x2 * sin, x2 * cos + x1 * sin], axis=-1)

    out = jnp.concatenate([rot(x[..., :half], row), rot(x[..., half:], col)], axis=-1)
    return out.astype(x.dtype)


def mla_attention(q_nope, q_rope, k_nope, k_rope, v):
    b, sq, h, _ = q_nope.shape
    nb = sq // Q_BLOCK
    scale = (QK_NOPE + QK_ROPE) ** -0.5

    def block(qs):
        qn, qr = qs
        s = jnp.einsum("bqhd,bkhd->bhqk", qn, k_nope) + jnp.einsum("bqhr,bkr->bhqk", qr, k_rope)
        p = jax.nn.softmax(s.astype(jnp.float32) * scale, axis=-1).astype(v.dtype)
        return jnp.einsum("bhqk,bkhd->bqhd", p, v)

    qn_b = q_nope.reshape(b, nb, Q_BLOCK, h, QK_NOPE).transpose(1, 0, 2, 3, 4)
    qr_b = q_rope.reshape(b, nb, Q_BLOCK, h, QK_ROPE).transpose(1, 0, 2, 3, 4)
    out = lax.map(block, (qn_b, qr_b))
    return out.transpose(1, 0, 2, 3, 4).reshape(b, sq, h * V_HEAD)


def depthwise_conv_centred(x, w, bias):
    l = x.shape[1]
    pad = D_CONV // 2
    xp = jnp.pad(x, ((0, 0), (pad, pad), (0, 0)))
    y = bias
    for k in range(D_CONV):
        y = y + xp[:, k:k + l] * w[k]
    return y


def ssd_chunked(x, dt, a, bm, cm, init_state):
    b, l, h, p = x.shape
    g, n = bm.shape[-2:]
    r = h // g
    c = l // CHUNK
    f32 = jnp.float32
    dt = dt.astype(f32)
    xr = (x.astype(f32) * dt[..., None]).reshape(b, c, CHUNK, g, r, p)
    da = (dt * a).reshape(b, c, CHUNK, g, r).transpose(0, 3, 4, 1, 2)
    bc = bm.astype(f32).reshape(b, c, CHUNK, g, n)
    cc = cm.astype(f32).reshape(b, c, CHUNK, g, n)
    a_cs = jnp.cumsum(da, axis=-1)
    seg = a_cs[..., :, None] - a_cs[..., None, :]
    causal = jnp.tril(jnp.ones((CHUNK, CHUNK), dtype=bool))
    lmat = jnp.exp(jnp.where(causal, seg, -jnp.inf))
    cb = jnp.einsum("bclgn,bcsgn->bgcls", cc, bc)
    y_diag = jnp.einsum("bgcls,bgrcls,bcsgrp->bclgrp", cb, lmat, xr)
    decay_states = jnp.exp(a_cs[..., -1:] - a_cs)
    chunk_states = jnp.einsum("bclgn,bgrcl,bclgrp->cbgrpn", bc, decay_states, xr)
    chunk_decay = jnp.exp(a_cs[..., -1]).transpose(3, 0, 1, 2)

    def step(state, inp):
        dec, st = inp
        return state * dec[..., None, None] + st, state

    final, entering = lax.scan(step, init_state.astype(f32).reshape(b, g, r, p, n),
                               (chunk_decay, chunk_states))
    y_off = jnp.einsum("bclgn,cbgrpn,bgrcl->bclgrp", cc, entering, jnp.exp(a_cs))
    y = (y_diag + y_off).reshape(b, l, h, p)
    return y, final.reshape(b, h, p, n)


def ssm_mixer(z, xbc, dt_f_raw, dt_b_raw, conv_w, conv_b, dt_bias, a_log, d_skip, g_out,
              init_f, init_b):
    b, l, _ = xbc.shape
    xbc = jax.nn.silu(depthwise_conv_centred(xbc, conv_w, conv_b))
    xs, bm, cm = jnp.split(xbc, [SSM_WIDTH, SSM_WIDTH + SSM_GROUPS * D_STATE], axis=-1)
    xs = xs.reshape(b, l, SSM_HEADS, SSM_HEAD_DIM)
    bm = bm.reshape(b, l, SSM_GROUPS, D_STATE)
    cm = cm.reshape(b, l, SSM_GROUPS, D_STATE)
    f32 = jnp.float32
    dt_f = jax.nn.softplus(dt_f_raw.astype(f32) + dt_bias[0].astype(f32))
    dt_b = jax.nn.softplus(dt_b_raw.astype(f32) + dt_bias[1].astype(f32))
    a_f = -jnp.exp(a_log[0].astype(f32))
    a_b = -jnp.exp(a_log[1].astype(f32))
    flip = lambda t: jnp.flip(t, axis=1)
    y_f, fin_f = ssd_chunked(xs, dt_f, a_f, bm, cm, init_f)
    y_b, fin_b = ssd_chunked(flip(xs), flip(dt_b), a_b, flip(bm), flip(cm), init_b)
    y = y_f + flip(y_b) + d_skip.astype(f32)[:, None] * xs.astype(f32)
    y = y.reshape(b, l, SSM_WIDTH) * jax.nn.silu(z.astype(f32))
    return rms_norm(y, g_out).astype(z.dtype), fin_f, fin_b


def split_in(proj):
    idx = np.cumsum([Q_LORA, KV_LORA, QK_ROPE, SSM_WIDTH, CONV_DIM, SSM_HEADS]).tolist()
    return jnp.split(proj, idx, axis=-1)


def token_mixing(h, w_in, g_q, w_uq, g_kv, w_ukv, conv_w, conv_b, dt_bias, a_log, d_skip,
                 g_ssm_out, w_out, ctx_ckv, ctx_krope, init_f, init_b):
    b, l, _ = h.shape
    q_c, kv_c, k_rope, z, xbc, dt_f, dt_b = split_in(h @ w_in)
    ckv = rms_norm(kv_c, g_kv)
    q = (rms_norm(q_c, g_q) @ w_uq).reshape(b, l, MLA_HEADS, QK_NOPE + QK_ROPE)
    q_nope, q_rope = q[..., :QK_NOPE], q[..., QK_NOPE:]
    if ctx_ckv is None:
        ckv_all, krope_all = ckv, k_rope
    else:
        q_rope = rope_2d(q_rope, l)
        ckv_all = jnp.concatenate([ctx_ckv, ckv], axis=1)
        krope_all = jnp.concatenate([ctx_krope, rope_2d(k_rope, l)], axis=1)
    sk = ckv_all.shape[1]
    kv = (ckv_all @ w_ukv).reshape(b, sk, MLA_HEADS, QK_NOPE + V_HEAD)
    k_nope, v = kv[..., :QK_NOPE], kv[..., QK_NOPE:]
    attn = mla_attention(q_nope, q_rope, k_nope, krope_all, v)
    ssm_out, fin_f, fin_b = ssm_mixer(z, xbc, dt_f, dt_b, conv_w, conv_b, dt_bias, a_log,
                                      d_skip, g_ssm_out, init_f, init_b)
    out = jnp.concatenate([attn, ssm_out], axis=-1) @ w_out
    return out, ckv, k_rope, fin_f, fin_b


def ffn_sublayer(x, shift, scale, gate, g_pre, g_post, w_gate, w_up, w_down):
    h = rms_norm(x, g_pre) * (1 + scale) + shift
    f = (jax.nn.silu(h @ w_gate) * (h @ w_up)) @ w_down
    return x + gate * rms_norm(f, g_post)


def setup_inputs(seed: int = 0) -> dict:
    key = jax.random.key(seed)
    ks = iter(jax.random.split(key, 32))
    nrm = lambda shape, s=1.0: jax.random.normal(next(ks), shape, jnp.float32) * s
    gain = lambda shape: 1.0 + 0.1 * jax.random.normal(next(ks), shape, jnp.float32)
    u = jax.random.uniform(next(ks), (DEPTH, 2, SSM_HEADS), jnp.float32)
    dt0 = jnp.exp(u * (math.log(0.1) - math.log(0.001)) + math.log(0.001))
    dt_bias = dt0 + jnp.log(-jnp.expm1(-dt0))
    a_log = jnp.log(jax.random.uniform(next(ks), (DEPTH, 2, SSM_HEADS), jnp.float32, 1.0, 16.0))
    return {
        "x_prompt": nrm((BATCH, SEQ, D_MODEL)),
        "x_sample": nrm((DEC_BATCH, DEC_SEQ, D_MODEL)),
        "cache_ckv": nrm((DEC_BATCH, DEPTH, PAST_LEN, KV_LORA)),
        "cache_krope": nrm((DEC_BATCH, DEPTH, PAST_LEN, QK_ROPE)),
        "state_ssm": nrm((DEC_BATCH, DEPTH, 2, SSM_HEADS, SSM_HEAD_DIM, D_STATE), 0.1),
        "c": nrm((DEC_BATCH, D_MODEL)),
        "c_ctx": nrm((D_MODEL,)),
        "w_mod": nrm((DEPTH, D_MODEL, 6 * D_MODEL), D_MODEL ** -0.5),
        "b_mod": nrm((DEPTH, 6 * D_MODEL), 0.01),
        "g_pre_mix": gain((DEPTH, D_MODEL)),
        "g_post_mix": gain((DEPTH, D_MODEL)),
        "w_in": nrm((DEPTH, D_MODEL, IN_WIDTH), D_MODEL ** -0.5),
        "g_q": gain((DEPTH, Q_LORA)),
        "w_uq": nrm((DEPTH, Q_LORA, MLA_HEADS * (QK_NOPE + QK_ROPE)), Q_LORA ** -0.5),
        "g_kv": gain((DEPTH, KV_LORA)),
        "w_ukv": nrm((DEPTH, KV_LORA, MLA_HEADS * (QK_NOPE + V_HEAD)), KV_LORA ** -0.5),
        "conv_w": nrm((DEPTH, D_CONV, CONV_DIM), D_CONV ** -0.5),
        "conv_b": nrm((DEPTH, CONV_DIM), 0.01),
        "dt_bias": dt_bias,
        "a_log": a_log,
        "d_skip": gain((DEPTH, SSM_HEADS)),
        "g_ssm_out": gain((DEPTH, SSM_WIDTH)),
        "w_out": nrm((DEPTH, MIX_WIDTH, D_MODEL), MIX_WIDTH ** -0.5),
        "g_pre_ffn": gain((DEPTH, D_MODEL)),
        "g_post_ffn": gain((DEPTH, D_MODEL)),
        "w_gate": nrm((DEPTH, D_MODEL, D_FF), D_MODEL ** -0.5),
        "w_up": nrm((DEPTH, D_MODEL, D_FF), D_MODEL ** -0.5),
        "w_down": nrm((DEPTH, D_FF, D_MODEL), D_FF ** -0.5),
    }


def reference(x_prompt, x_sample, cache_ckv, cache_krope, state_ssm, c, c_ctx, w_mod, b_mod,
              g_pre_mix, g_post_mix, w_in, g_q, w_uq, g_kv, w_ukv, conv_w, conv_b, dt_bias,
              a_log, d_skip, g_ssm_out, w_out, g_pre_ffn, g_post_ffn, w_gate, w_up, w_down):
    y_p = x_prompt
    y_s = x_sample
    new_ckv, new_krope, new_ssm = [], [], []
    zero_state = jnp.zeros((x_prompt.shape[0], SSM_HEADS, SSM_HEAD_DIM, D_STATE), jnp.float32)
    for l in range(DEPTH):
        mix_args = (w_in[l], g_q[l], w_uq[l], g_kv[l], w_ukv[l], conv_w[l], conv_b[l],
                    dt_bias[l], a_log[l], d_skip[l], g_ssm_out[l], w_out[l])
        ffn_args = (g_pre_ffn[l], g_post_ffn[l], w_gate[l], w_up[l], w_down[l])

        sh1, sc1, gt1, sh2, sc2, gt2 = adaln(c_ctx, w_mod[l], b_mod[l])
        h = rms_norm(y_p, g_pre_mix[l]) * (1 + sc1) + sh1
        out, ckv, k_rope, fin_f, fin_b = token_mixing(h, *mix_args, None, None,
                                                      zero_state, zero_state)
        y_p = y_p + gt1 * rms_norm(out, g_post_mix[l])
        y_p = ffn_sublayer(y_p, sh2, sc2, gt2, *ffn_args)
        new_ckv.append(ckv)
        new_krope.append(k_rope)
        new_ssm.append(jnp.stack([fin_f, fin_b], axis=1).astype(x_prompt.dtype))

        sh1, sc1, gt1, sh2, sc2, gt2 = adaln(c, w_mod[l], b_mod[l])
        h = rms_norm(y_s, g_pre_mix[l]) * (1 + sc1) + sh1
        out, _, _, _, _ = token_mixing(h, *mix_args, cache_ckv[:, l], cache_krope[:, l],
                                       state_ssm[:, l, 0], state_ssm[:, l, 1])
        y_s = y_s + gt1 * rms_norm(out, g_post_mix[l])
        y_s = ffn_sublayer(y_s, sh2, sc2, gt2, *ffn_args)

    new_cache_ckv = jnp.stack(new_ckv, axis=1)
    new_cache_krope = jnp.stack(new_krope, axis=1)
    new_state_ssm = jnp.stack(new_ssm, axis=1)
    return (y_p, y_s, new_cache_ckv, new_cache_krope, new_state_ssm)
```

```cpp
#include <hip/hip_runtime.h>
#include <hip/hip_cooperative_groups.h>
#include <cstdio>
#include <cstdint>
namespace cg = cooperative_groups;

#ifndef MK_SPLIT
#define MK_SPLIT 0
#endif

#define DI __device__ __forceinline__
#define LAS __attribute__((address_space(3)))
typedef unsigned short bf16;
typedef float f32x4 __attribute__((ext_vector_type(4)));
typedef float f32x16 __attribute__((ext_vector_type(16)));
typedef short bf16x8 __attribute__((ext_vector_type(8)));
typedef short s16x4 __attribute__((ext_vector_type(4)));
typedef unsigned u32x4 __attribute__((ext_vector_type(4)));
typedef unsigned u32x2 __attribute__((ext_vector_type(2)));
typedef float f32x2_t __attribute__((ext_vector_type(2)));

namespace pg8 {
#define PG8_LAS __attribute__((address_space(3)))
typedef unsigned short bf16_t;
typedef short bf16x8 __attribute__((ext_vector_type(8)));
typedef float f32x4 __attribute__((ext_vector_type(4)));
typedef unsigned u32x4 __attribute__((ext_vector_type(4)));
constexpr int BM = 256, BK = 64, HALF = 128, HTB = HALF * BK * 2, STAGE_BYTES = 8 * HTB, NXCD = 8, WGM = 8;

__host__ __device__ __forceinline__ int lds_byte(int r, int c) { const int st = (r >> 4) * 2 + (c >> 5), rr = r & 15, cc = c & 31, ob = rr * 64 + cc * 2; return st * 1024 + (ob ^ (((ob >> 9) & 1) << 5)); }
__host__ __device__ __forceinline__ void stage_rc(int b, int& R, int& C) { const int st = b / 1024, sb = b % 1024, swz = sb ^ (((sb >> 9) & 1) << 5); R = (st >> 1) * 16 + swz / 64; C = (st & 1) * 32 + (swz % 64) / 2; }
__host__ __device__ __forceinline__ int perm32(int rho) { const int n = rho >> 4, i = rho & 15; return 8 * (i >> 2) + 4 * n + (i & 3); }

struct Unit { int pm, pn; };
struct Gemm { const bf16_t* A; const bf16_t* Bt; int M, N, K; };

struct StaticOrder {
    int nM, nN, nwg, G, c;
    __host__ __device__ void init(int M, int N, int G_, int c_) { nM = M / BM; nN = N / BM; nwg = nM * nN; G = G_; c = c_; }
    __host__ __device__ bool next(int i, Unit& u) const {
        const long L = (long)i * G + c; if (L >= nwg) return false;
        int wgid = (int)L; { const int q = nwg / NXCD, r = nwg % NXCD, xcd = wgid % NXCD, off = wgid / NXCD; wgid = (xcd < r ? xcd * (q + 1) : r * (q + 1) + (xcd - r) * q) + off; }
        const int nig = WGM * nN, gid = wgid / nig, fm = gid * WGM, gsz = (nM - fm) < WGM ? (nM - fm) : WGM;
        u.pm = fm + ((wgid % nig) % gsz); u.pn = (wgid % nig) / gsz; return true;
    }
    __device__ __forceinline__ void a_ready(const Unit&) const {}
    __device__ __forceinline__ void done(const Unit&) const {}
};

template <class Epi, class Sched, bool ALIGN_EPI = false, bool SP2 = false>
__device__ __forceinline__ void gemm_phase(PG8_LAS unsigned char* lds, const Gemm g, const Sched& S, const Epi& E) {
    const int tid = threadIdx.x, wid = __builtin_amdgcn_readfirstlane(tid >> 6), lane = tid & 63, wr = wid >> 2, wc = wid & 3, fr = lane & 15, fq = lane >> 4;
    int Kop = g.K; asm volatile("" : "+s"(Kop));
    const int K = Kop, nt = K / BK;
    unsigned voffA[2], voffB[2];
#pragma unroll
    for (int i = 0; i < 2; ++i) { int R, C; stage_rc(tid * 16 + i * 8192, R, C); const int Rb = Epi::PERM ? ((R & ~31) + perm32(R & 31)) : R;
        voffA[i] = (unsigned)(R * K + C) * 2u; voffB[i] = (unsigned)(Rb * K + C) * 2u; }
    const size_t kstep = (size_t)(BK * 2);
    const size_t hstep = (size_t)HALF * K * 2;
    const size_t tstep = 2 * hstep;
    const unsigned ldsw = (unsigned)wid * 1024u;
    const int aoff = lds_byte(wr * 64 + fr, fq * 8), boff = lds_byte(wc * 32 + fr, fq * 8);
#define PG8_SA(b, h) (((b) * 2 + (h)) * HTB)
#define PG8_SB(b, h) ((4 + (b) * 2 + (h)) * HTB)
#define PG8_STAGE(bufoff, gbase, voff) do { _Pragma("unroll") for (int _i = 0; _i < 2; ++_i) \
        __builtin_amdgcn_global_load_lds((const unsigned*)((const char*)(gbase) + (voff)[_i]), (PG8_LAS unsigned*)(lds + (bufoff) + ldsw + _i * 8192), 16, 0, 0); } while (0)
#define PG8_LDA(dst, b, h) do { _Pragma("unroll") for (int m = 0; m < 4; ++m) _Pragma("unroll") for (int k = 0; k < 2; ++k) dst[m][k] = *(const PG8_LAS bf16x8*)(lds + PG8_SA(b, h) + aoff + m * 2048 + k * 1024); } while (0)
#define PG8_LDB(dst, b, h) do { _Pragma("unroll") for (int n = 0; n < 2; ++n) _Pragma("unroll") for (int k = 0; k < 2; ++k) dst[n][k] = *(const PG8_LAS bf16x8*)(lds + PG8_SB(b, h) + boff + n * 2048 + k * 1024); } while (0)
#define PG8_MMA(ai, bj, At, Bt) do { __builtin_amdgcn_s_setprio(1); _Pragma("unroll") for (int m = 0; m < 4; ++m) _Pragma("unroll") for (int n = 0; n < 2; ++n) _Pragma("unroll") for (int k = 0; k < 2; ++k) \
        acc[ai][bj][m][n] = __builtin_amdgcn_mfma_f32_16x16x32_bf16(Bt[n][k], At[m][k], acc[ai][bj][m][n], 0, 0, 0); __builtin_amdgcn_s_setprio(0); } while (0)
#define PG8_WAIT_V(n) asm volatile("s_waitcnt vmcnt(" #n ")" ::: "memory")
#define PG8_WAIT_L(n) asm volatile("s_waitcnt lgkmcnt(" #n ")" ::: "memory")
#define PG8_BAR __builtin_amdgcn_s_barrier()
#define PG8_SCHED __builtin_amdgcn_sched_barrier(0)
    Unit cur, nxt; int ui = 0;
    if (!S.next(0, cur)) return;
    f32x4 acc[2][2][4][2];
#pragma unroll
    for (int a = 0; a < 2; ++a)
#pragma unroll
        for (int b = 0; b < 2; ++b)
#pragma unroll
            for (int m = 0; m < 4; ++m)
#pragma unroll
                for (int n = 0; n < 2; ++n) acc[a][b][m][n] = (f32x4){0.f, 0.f, 0.f, 0.f};
    bf16x8 At[4][2], B0[2][2], B1[2][2];
    const char* cA = (const char*)g.A + (size_t)cur.pm * tstep; const char* cB = (const char*)g.Bt + (size_t)cur.pn * tstep;
    S.a_ready(cur);
    if constexpr (SP2) {
        PG8_STAGE(PG8_SB(0, 0), cB, voffB); PG8_STAGE(PG8_SB(0, 1), cB + hstep, voffB); PG8_STAGE(PG8_SA(0, 0), cA, voffA); PG8_STAGE(PG8_SA(0, 1), cA + hstep, voffA);
        if (wr == 1) PG8_BAR;
        PG8_WAIT_V(2); PG8_BAR;
        PG8_STAGE(PG8_SB(1, 0), cB + kstep, voffB); PG8_STAGE(PG8_SA(1, 0), cA + kstep, voffA); PG8_STAGE(PG8_SB(1, 1), cB + hstep + kstep, voffB);
        PG8_WAIT_V(6); PG8_BAR;
    } else {
        PG8_STAGE(PG8_SB(0, 0), cB, voffB); PG8_STAGE(PG8_SA(0, 0), cA, voffA); PG8_STAGE(PG8_SB(0, 1), cB + hstep, voffB); PG8_STAGE(PG8_SA(0, 1), cA + hstep, voffA);
        if (wr == 1) PG8_BAR;
        PG8_WAIT_V(4); PG8_BAR;
        PG8_STAGE(PG8_SB(1, 0), cB + kstep, voffB); PG8_STAGE(PG8_SA(1, 0), cA + kstep, voffA); PG8_STAGE(PG8_SB(1, 1), cB + hstep + kstep, voffB);
        PG8_WAIT_V(6); PG8_BAR;
    }
    for (;;) {
        const bool has_next = S.next(ui + 1, nxt);
        const char* nA = has_next ? (const char*)g.A + (size_t)nxt.pm * tstep : cA; const char* nB = has_next ? (const char*)g.Bt + (size_t)nxt.pn * tstep : cB;
#pragma unroll 1
        for (int t = 0; t < nt; t += 2) {
            const bool last = (t == nt - 2);
            const char* a1 = cA + (size_t)(t + 1) * kstep;
            const char* a2 = last ? nA : cA + (size_t)(t + 2) * kstep; const char* b2 = last ? nB : cB + (size_t)(t + 2) * kstep;
            const char* a3 = a2 + kstep; const char* b3 = b2 + kstep;
            if (last && has_next) S.a_ready(nxt);
            if constexpr (SP2) {
            PG8_LDB(B0, 0, 0); PG8_LDB(B1, 0, 1); PG8_SCHED; PG8_LDA(At, 0, 0); PG8_STAGE(PG8_SA(1, 1), a1 + hstep, voffA);
            PG8_WAIT_V(8); PG8_WAIT_L(0); PG8_BAR; PG8_MMA(0, 0, At, B0); PG8_MMA(0, 1, At, B1); PG8_BAR; PG8_SCHED;
            PG8_LDA(At, 0, 1); PG8_STAGE(PG8_SB(0, 0), b2, voffB); PG8_STAGE(PG8_SB(0, 1), b2 + hstep, voffB); PG8_STAGE(PG8_SA(0, 0), a2, voffA);
            PG8_WAIT_V(8); PG8_WAIT_L(0); PG8_BAR; PG8_MMA(1, 0, At, B0); PG8_MMA(1, 1, At, B1); PG8_BAR; PG8_SCHED;
            PG8_LDB(B0, 1, 0); PG8_LDB(B1, 1, 1); PG8_SCHED; PG8_LDA(At, 1, 0); PG8_STAGE(PG8_SA(0, 1), a2 + hstep, voffA);
            PG8_WAIT_V(8); PG8_WAIT_L(0); PG8_BAR; PG8_MMA(0, 0, At, B0); PG8_MMA(0, 1, At, B1); PG8_BAR; PG8_SCHED;
            PG8_LDA(At, 1, 1); PG8_STAGE(PG8_SB(1, 0), b3, voffB); PG8_STAGE(PG8_SB(1, 1), b3 + hstep, voffB); PG8_STAGE(PG8_SA(1, 0), a3, voffA);
            PG8_WAIT_V(8); PG8_WAIT_L(0); PG8_BAR; PG8_MMA(1, 0, At, B0); PG8_MMA(1, 1, At, B1); PG8_BAR; PG8_SCHED;
            } else {
            PG8_LDB(B0, 0, 0); PG8_SCHED; PG8_LDA(At, 0, 0); PG8_STAGE(PG8_SA(1, 1), a1 + hstep, voffA);
            PG8_WAIT_L(8); PG8_BAR; PG8_WAIT_L(0); PG8_MMA(0, 0, At, B0); PG8_BAR; PG8_SCHED;
            PG8_LDB(B1, 0, 1); PG8_STAGE(PG8_SB(0, 0), b2, voffB);
            PG8_BAR; PG8_WAIT_L(0); PG8_MMA(0, 1, At, B1); PG8_BAR;
            PG8_LDA(At, 0, 1); PG8_STAGE(PG8_SA(0, 0), a2, voffA);
            PG8_BAR; PG8_WAIT_L(0); PG8_MMA(1, 0, At, B0); PG8_BAR; PG8_SCHED;
            PG8_STAGE(PG8_SB(0, 1), b2 + hstep, voffB);
            PG8_WAIT_V(6); PG8_BAR; PG8_MMA(1, 1, At, B1); PG8_BAR;
            PG8_LDB(B0, 1, 0); PG8_SCHED; PG8_LDA(At, 1, 0); PG8_STAGE(PG8_SA(0, 1), a2 + hstep, voffA);
            PG8_WAIT_L(8); PG8_BAR; PG8_WAIT_L(0); PG8_MMA(0, 0, At, B0); PG8_BAR; PG8_SCHED;
            PG8_LDB(B1, 1, 1); PG8_STAGE(PG8_SB(1, 0), b3, voffB);
            PG8_BAR; PG8_WAIT_L(0); PG8_MMA(0, 1, At, B1); PG8_BAR;
            PG8_LDA(At, 1, 1); PG8_STAGE(PG8_SA(1, 0), a3, voffA);
            PG8_BAR; PG8_WAIT_L(0); PG8_MMA(1, 0, At, B0); PG8_BAR; PG8_SCHED;
            PG8_STAGE(PG8_SB(1, 1), b3 + hstep, voffB);
            PG8_WAIT_V(6); PG8_BAR; PG8_MMA(1, 1, At, B1); PG8_BAR;
            }
        }
        if constexpr (ALIGN_EPI) { if (wr == 0) PG8_BAR; }
        if constexpr (!Epi::AFTER_DRAIN) { E(acc, cur, wr, wc, fr, fq); S.done(cur); }
        if (!has_next) break;
#pragma unroll
        for (int a = 0; a < 2; ++a)
#pragma unroll
            for (int b = 0; b < 2; ++b)
#pragma unroll
                for (int m = 0; m < 4; ++m)
#pragma unroll
                    for (int n = 0; n < 2; ++n) acc[a][b][m][n] = (f32x4){0.f, 0.f, 0.f, 0.f};
        cur = nxt; cA = nA; cB = nB; ++ui;
        if constexpr (ALIGN_EPI) { if (wr == 1) PG8_BAR; }
    }
    PG8_WAIT_V(0);
    if constexpr (!ALIGN_EPI) { if (wr == 0) PG8_BAR; }
    PG8_BAR;
    if constexpr (Epi::AFTER_DRAIN) { E.fused(acc, cur, wr, wc, fr, fq, lds, wid, lane); }
#undef PG8_SA
#undef PG8_SB
#undef PG8_STAGE
#undef PG8_LDA
#undef PG8_LDB
#undef PG8_MMA
#undef PG8_WAIT_V
#undef PG8_WAIT_L
#undef PG8_BAR
#undef PG8_SCHED
}
}

constexpr int DM = 1024, NCTX = 8192, NTOK = 16384, NKROW = 18432;
constexpr int IN_W = 2256, IN_WP = 2304, DFF = 2816;
constexpr float NORM_EPS = 1e-6f;
constexpr float QSCALE = 0.07216878364870322f * 1.4426950408889634f;

constexpr size_t MiB = 1u << 20;
constexpr size_t WS_MOD = 1 * MiB, WS_ROPE = 1 * MiB + 512 * 1024;
constexpr size_t WS_WIN = 2 * MiB, WS_WUQ = 6 * MiB + 512 * 1024, WS_WKN = 7 * MiB + 256 * 1024, WS_WV = 7 * MiB + 512 * 1024, WS_WOUT = 8 * MiB, WS_WGU = 10 * MiB, WS_WDN = 21 * MiB;
constexpr size_t WS_DTR = 27 * MiB, WS_DT = 28 * MiB;
constexpr size_t WS_H = 30 * MiB, WS_PA = 62 * MiB, WS_Z = 84 * MiB, WS_XBC = 100 * MiB, WS_QN = 132 * MiB, WS_CKV = 144 * MiB, WS_KR = 153 * MiB, WS_XS = 156 * MiB;
constexpr size_t WS_YF = 188 * MiB, WS_YB = 220 * MiB;
constexpr size_t WS_Q = 30 * MiB, WS_KN = 54 * MiB, WS_VT = 100 * MiB, WS_MIX = 118 * MiB, WS_OM = 150 * MiB, WS_ACT = 62 * MiB, WS_F = 150 * MiB;
constexpr size_t WS_Y1 = 150 * MiB;
constexpr int LDS_BYTES = 147456;

DI unsigned pk2(float lo, float hi) { unsigned r; asm volatile("v_cvt_pk_bf16_f32 %0, %1, %2" : "=v"(r) : "v"(lo), "v"(hi)); return r; }
DI float bflo(unsigned u) { return __uint_as_float(u << 16); }
DI float bfhi(unsigned u) { return __uint_as_float(u & 0xffff0000u); }
DI float bf2f(unsigned short b) { return __uint_as_float((unsigned)b << 16); }
DI unsigned short f2bf1(float f) { return (unsigned short)(pk2(f, 0.f) & 0xffffu); }
DI float wave_sum(float v) {
#pragma unroll
    for (int o = 1; o < 64; o <<= 1) v += __shfl_xor(v, o);
    return v;
}
DI float silu_f(float v) { return v * __builtin_amdgcn_rcpf(1.f + __expf(-v)); }
DI int crow(int i, int h) { return (i & 3) + 8 * (i >> 2) + 4 * h; }
#define LDS_WAIT() asm volatile("s_waitcnt lgkmcnt(0)" ::: "memory")
#define MFMA32(a, b, c) __builtin_amdgcn_mfma_f32_32x32x16_bf16((a), (b), (c), 0, 0, 0)
#define MFMA16(a, b, c) __builtin_amdgcn_mfma_f32_16x16x32_bf16((a), (b), (c), 0, 0, 0)

template <class F> struct Epi8 {
    static constexpr bool PERM = true, AFTER_DRAIN = false;
    F f;
    DI void operator()(const f32x4 (&acc)[2][2][4][2], const pg8::Unit& u, int wr, int wc, int fr, int fq) const {
        const int row0 = u.pm * 256 + wr * 64 + fr, col0 = u.pn * 256 + wc * 32 + 8 * fq;
#pragma unroll
        for (int ai = 0; ai < 2; ++ai)
#pragma unroll
            for (int m = 0; m < 4; ++m)
#pragma unroll
                for (int bj = 0; bj < 2; ++bj) f(row0 + ai * 128 + m * 16, col0 + bj * 128, acc[ai][bj][m][0], acc[ai][bj][m][1]);
    }
};
DI void st8bf(bf16* p, f32x4 v0, f32x4 v1) { u32x4 w; w.x = pk2(v0[0], v0[1]); w.y = pk2(v0[2], v0[3]); w.z = pk2(v1[0], v1[1]); w.w = pk2(v1[2], v1[3]); *(u32x4*)p = w; }
DI void st8f(float* p, f32x4 v0, f32x4 v1) { *(f32x4*)p = v0; *(f32x4*)(p + 4) = v1; }

struct FInProj { bf16* PA; bf16* Z; bf16* XBC; float* DTR;
    DI void operator()(int row, int col, f32x4 v0, f32x4 v1) const {
        if (col < 704) st8bf(PA + (size_t)row * 704 + col, v0, v1);
        else if (col < 1216) st8bf(Z + (size_t)row * 512 + (col - 704), v0, v1);
        else if (col < 2240) st8bf(XBC + (size_t)row * 1024 + (col - 1216), v0, v1);
        else if (col < 2256) st8f(DTR + (size_t)row * 16 + (col - 2240), v0, v1);
    }
};
struct FQUp { bf16* Q;
    DI void operator()(int row, int col, f32x4 v0, f32x4 v1) const { st8bf(Q + (size_t)row * 768 + col, v0 * QSCALE, v1 * QSCALE); }
};
struct FBf { bf16* O; int ld; DI void operator()(int row, int col, f32x4 v0, f32x4 v1) const { st8bf(O + (size_t)row * ld + col, v0, v1); } };
struct FF32 { float* O; int ld; DI void operator()(int row, int col, f32x4 v0, f32x4 v1) const { st8f(O + (size_t)row * ld + col, v0, v1); } };
struct FGateUp { bf16* ACT;
    DI void operator()(int row, int col, f32x4 g, f32x4 u) const {
        u32x2 w; w.x = pk2(silu_f(g[0]) * u[0], silu_f(g[1]) * u[1]); w.y = pk2(silu_f(g[2]) * u[2], silu_f(g[3]) * u[3]);
        *(u32x2*)(ACT + (size_t)row * DFF + (col >> 1)) = w;
    }
};

template <int MODE  >
DI void tr_item(const float* W, int K, int N, bf16* WT, LAS float* scr, int kb, int nb, int lane, int dst_row0) {
    const int k0 = 64 * kb, n0 = 32 * nb, nn = n0 + (lane & 31);
#pragma unroll
    for (int i = 0; i < 32; ++i) { const int kk = 2 * i + (lane >> 5); scr[kk * 33 + (lane & 31)] = (nn < N) ? __builtin_nontemporal_load(W + (size_t)(k0 + kk) * N + nn) : 0.f; }
    LDS_WAIT(); asm volatile("" ::: "memory");
    const int c = lane & 7;
#pragma unroll
    for (int j = 0; j < 4; ++j) { const int nl = (lane >> 3) + 8 * j; const LAS float* s = scr + (8 * c) * 33 + nl;
        u32x4 o; o.x = pk2(s[0 * 33], s[1 * 33]); o.y = pk2(s[2 * 33], s[3 * 33]); o.z = pk2(s[4 * 33], s[5 * 33]); o.w = pk2(s[6 * 33], s[7 * 33]);
        const int f = n0 + nl;
        const int row = (MODE == 0) ? (dst_row0 + nl) : ((f >> 2) * 8 + (MODE == 2 ? 4 : 0) + (f & 3));
        *(u32x4*)(WT + (size_t)row * K + k0 + 8 * c) = o; }
    LDS_WAIT(); asm volatile("" ::: "memory");
}

DI void phase0(LAS unsigned char* lds, const float* const* in, unsigned char* ws, int G) {
    const int tid = threadIdx.x, lane = tid & 63, wave = tid >> 6, bx = blockIdx.x;
    const float* c = in[5]; const float* c_ctx = in[6]; const float* w_mod = in[7]; const float* b_mod = in[8];
    float* mod = (float*)(ws + WS_MOD);
    if (bx < 192) {
        LAS float* sc = (LAS float*)lds;
        LAS float* red = (LAS float*)(lds + 36864);
        for (int i = tid; i < 9 * 1024; i += 512) { const int j = i >> 10, k = i & 1023; const float v = (j == 0) ? c_ctx[k] : c[(j - 1) * 1024 + k]; sc[i] = v / (1.f + expf(-v)); }
        __syncthreads();
        for (int item = bx; item < 192; item += G) {
            const int cc = tid & 31, kg = tid >> 5, col = item * 32 + cc;
            float a0 = 0.f, a1 = 0.f, a2 = 0.f, a3 = 0.f, a4 = 0.f, a5 = 0.f, a6 = 0.f, a7 = 0.f, a8 = 0.f;
#pragma unroll 16
            for (int i = 0; i < 64; ++i) { const int k = kg * 64 + i; const float w = __builtin_nontemporal_load(w_mod + (size_t)k * 6144 + col);
                a0 += sc[k] * w; a1 += sc[1024 + k] * w; a2 += sc[2048 + k] * w; a3 += sc[3072 + k] * w; a4 += sc[4096 + k] * w;
                a5 += sc[5120 + k] * w; a6 += sc[6144 + k] * w; a7 += sc[7168 + k] * w; a8 += sc[8192 + k] * w; }
            LAS float* rp = red + kg * 288 + cc;
            rp[0] = a0; rp[32] = a1; rp[64] = a2; rp[96] = a3; rp[128] = a4; rp[160] = a5; rp[192] = a6; rp[224] = a7; rp[256] = a8;
            __syncthreads();
            if (tid < 288) { const int j = tid >> 5, c2 = tid & 31; float s = b_mod[item * 32 + c2];
#pragma unroll
                for (int q = 0; q < 16; ++q) s += red[q * 288 + j * 32 + c2];
                mod[j * 6144 + item * 32 + c2] = s; }
            __syncthreads();
        }
    }
    if (bx == G - 1) {
        float* T = (float*)(ws + WS_ROPE);
        for (int e = tid; e < 1024; e += 512) { const int pos = e >> 4, i = e & 15;
            const float invf = exp2f(-(float)i * (13.287712379549449f / 16.f));
            const float ang = (float)pos * invf;
            const float n = rintf(ang * 0.15915494309189535f);
            float r = fmaf(-n, 6.28125f, ang); r = fmaf(-n, 1.9353071795864769e-3f, r);
            T[2 * e] = cosf(r); T[2 * e + 1] = sinf(r); }
    }
    __syncthreads();
    LAS float* scr = (LAS float*)(lds + 57344 + wave * 8704);
    const int gw = bx * 8 + wave, NGW = G * 8;
    constexpr int I_IN = 16 * 72, I_UQ = 6 * 24, I_KV = 4 * 32, I_OUT = 16 * 32;
    constexpr int NITEMS = I_IN + I_UQ + I_KV + I_OUT;
    for (int it = gw; it < NITEMS; it += NGW) {
        int r = it;
        if (r < I_IN) { const int kb = r / 72, nb = r % 72; tr_item<0>(in[11], 1024, IN_W, (bf16*)(ws + WS_WIN), scr, kb, nb, lane, 32 * nb); continue; } r -= I_IN;
        if (r < I_UQ) { const int kb = r / 24, nb = r % 24; tr_item<0>(in[13], 384, 768, (bf16*)(ws + WS_WUQ), scr, kb, nb, lane, 32 * nb); continue; } r -= I_UQ;
        if (r < I_KV) { const int kb = r / 32, nb = r % 32, c0 = 32 * nb, hh = c0 >> 8, e0 = c0 & 255;
            if (e0 < 128) tr_item<0>(in[15], 256, 1024, (bf16*)(ws + WS_WKN), scr, kb, nb, lane, hh * 128 + e0);
            else tr_item<0>(in[15], 256, 1024, (bf16*)(ws + WS_WV), scr, kb, nb, lane, hh * 128 + e0 - 128);
            continue; } r -= I_KV;
        { const int kb = r / 32, nb = r % 32; tr_item<0>(in[22], 1024, 1024, (bf16*)(ws + WS_WOUT), scr, kb, nb, lane, 32 * nb); }
    }
}
DI void ffn_weight_copies(LAS unsigned char* lds, const float* const* in, unsigned char* ws, int gw, int NGW) {
    const int lane = threadIdx.x & 63, wave = threadIdx.x >> 6;
    LAS float* scr = (LAS float*)(lds + 57344 + wave * 8704);
    constexpr int I_G = 16 * 88, I_DN = 44 * 32;
    for (int it = gw; it < 2 * I_G + I_DN; it += NGW) {
        int r = it;
        if (r < I_G) { const int kb = r / 88, nb = r % 88; tr_item<1>(in[25], 1024, DFF, (bf16*)(ws + WS_WGU), scr, kb, nb, lane, 0); continue; } r -= I_G;
        if (r < I_G) { const int kb = r / 88, nb = r % 88; tr_item<2>(in[26], 1024, DFF, (bf16*)(ws + WS_WGU), scr, kb, nb, lane, 0); continue; } r -= I_G;
        { const int kb = r / 32, nb = r % 32; tr_item<0>(in[27], DFF, 1024, (bf16*)(ws + WS_WDN), scr, kb, nb, lane, 32 * nb); }
    }
}

DI const float* xrow_ptr(const float* const* in, int r) { return (r < NCTX) ? in[0] + (size_t)r * DM : in[1] + (size_t)(r - NCTX) * DM; }
DI int mod_idx(int r) { return (r < NCTX) ? 0 : 1 + ((r - NCTX) >> 10); }

DI void phase1(const float* const* in, unsigned char* ws, int G) {
    const int lane = threadIdx.x & 63, wave = threadIdx.x >> 6, gw = blockIdx.x * 8 + wave, NGW = G * 8;
    const float* mod = (const float*)(ws + WS_MOD); const float* gp = in[9]; bf16* H = (bf16*)(ws + WS_H);
    f32x4 g[4];
#pragma unroll
    for (int j = 0; j < 4; ++j) g[j] = *(const f32x4*)(gp + 4 * lane + 256 * j);
    for (int r0 = gw; r0 < NTOK; r0 += 4 * NGW) {
        f32x4 v[4][4]; float s[4];
#pragma unroll
        for (int q = 0; q < 4; ++q) { const int r = r0 + q * NGW; const f32x4* xr = (const f32x4*)xrow_ptr(in, r < NTOK ? r : r0) + lane;
#pragma unroll
            for (int j = 0; j < 4; ++j) v[q][j] = __builtin_nontemporal_load(xr + 64 * j); }
#pragma unroll
        for (int q = 0; q < 4; ++q) { s[q] = 0.f;
#pragma unroll
            for (int j = 0; j < 4; ++j) s[q] += v[q][j].x * v[q][j].x + v[q][j].y * v[q][j].y + v[q][j].z * v[q][j].z + v[q][j].w * v[q][j].w; }
#pragma unroll
        for (int o = 1; o < 64; o <<= 1) {
#pragma unroll
            for (int q = 0; q < 4; ++q) s[q] += __shfl_xor(s[q], o); }
#pragma unroll
        for (int q = 0; q < 4; ++q) { const int r = r0 + q * NGW; if (r >= NTOK) break;
            const float rstd = rsqrtf(s[q] * (1.f / DM) + NORM_EPS); const float* mj = mod + mod_idx(r) * 6144;
            u32x2* o = (u32x2*)(H + (size_t)r * DM) + lane;
#pragma unroll
            for (int j = 0; j < 4; ++j) { const int k = 4 * lane + 256 * j;
                const f32x4 sc = *(const f32x4*)(mj + 1024 + k), sh = *(const f32x4*)(mj + k);
                const f32x4 h = v[q][j] * rstd * g[j] * (sc + 1.f) + sh;
                u32x2 w; w.x = pk2(h.x, h.y); w.y = pk2(h.z, h.w); o[64 * j] = w; } }
    }
}

struct P3Row { unsigned q0, q1, q2, k0, k1; unsigned short kr; u32x4 m1[2], c0[2], p1[2]; float dtr; };
DI void p3_load(P3Row& R, const bf16* PA, const bf16* XBC, const float* DTR, int r, int lane) {
    const bool ctx = r < NCTX; const int l = ctx ? (r & 255) : ((r - NCTX) & 1023), L = ctx ? 256 : 1024;
    const unsigned* pa = (const unsigned*)(PA + (size_t)r * 704);
    R.q0 = pa[lane]; R.q1 = pa[lane + 64]; R.q2 = pa[lane + 128]; R.k0 = pa[192 + lane]; R.k1 = pa[256 + lane];
    R.kr = PA[(size_t)r * 704 + 640 + lane];
    const u32x4 z4 = {0u, 0u, 0u, 0u};
#pragma unroll
    for (int jj = 0; jj < 2; ++jj) { const int ch = 8 * lane + 512 * jj;
        R.m1[jj] = (l > 0) ? *(const u32x4*)(XBC + (size_t)(r - 1) * 1024 + ch) : z4;
        R.c0[jj] = *(const u32x4*)(XBC + (size_t)r * 1024 + ch);
        R.p1[jj] = (l < L - 1) ? *(const u32x4*)(XBC + (size_t)(r + 1) * 1024 + ch) : z4; }
    R.dtr = DTR[(size_t)r * 16 + (lane & 15)];
}
DI void phase3(const float* const* in, float* out, unsigned char* ws, int G) {
    const int lane = threadIdx.x & 63, wave = threadIdx.x >> 6, gw = blockIdx.x * 8 + wave, NGW = G * 8;
    const bf16* PA = (const bf16*)(ws + WS_PA); const bf16* XBC = (const bf16*)(ws + WS_XBC);
    const float* DTR = (const float*)(ws + WS_DTR); float* DT = (float*)(ws + WS_DT);
    bf16* QN = (bf16*)(ws + WS_QN); bf16* CKV = (bf16*)(ws + WS_CKV); bf16* KR = (bf16*)(ws + WS_KR); bf16* XS = (bf16*)(ws + WS_XS);
    const float* rope = (const float*)(ws + WS_ROPE);
    const float* g_q = in[12]; const float* g_kv = in[14]; const float* conv_w = in[16]; const float* conv_b = in[17]; const float* dt_bias = in[18];
    float* out_ckv = out + 2 * (size_t)NCTX * DM; float* out_kr = out_ckv + (size_t)NCTX * 256;
    for (int rr = gw; rr < 2048; rr += NGW) {
        const int b = rr >> 8, j = rr & 255; const size_t krow = (size_t)NCTX + b * 1280 + j;
        const f32x4 v = __builtin_nontemporal_load((const f32x4*)(in[2] + (size_t)rr * 256) + lane);
        u32x2 w; w.x = pk2(v.x, v.y); w.y = pk2(v.z, v.w); *((u32x2*)(CKV + krow * 256) + lane) = w;
        KR[krow * 64 + lane] = f2bf1(in[3][(size_t)rr * 64 + lane]);
    }
    const float gq0 = g_q[2 * lane], gq1 = g_q[2 * lane + 1], gq2 = g_q[2 * lane + 128], gq3 = g_q[2 * lane + 129], gq4 = g_q[2 * lane + 256], gq5 = g_q[2 * lane + 257];
    const float gk0 = g_kv[2 * lane], gk1 = g_kv[2 * lane + 1], gk2 = g_kv[2 * lane + 128], gk3 = g_kv[2 * lane + 129];
    const float dtb = dt_bias[lane & 15];
    P3Row cur, nxt;
    if (gw < NTOK) p3_load(cur, PA, XBC, DTR, gw, lane);
    for (int r = gw; r < NTOK; r += NGW) {
        if (r + NGW < NTOK) p3_load(nxt, PA, XBC, DTR, r + NGW, lane);
        const bool ctx = r < NCTX;
        const int bl = ctx ? (r >> 8) : ((r - NCTX) >> 10), l = ctx ? (r & 255) : ((r - NCTX) & 1023);
        const size_t krow = ctx ? (size_t)r : (size_t)NCTX + bl * 1280 + 256 + l;
        { float a0 = bflo(cur.q0), a1 = bfhi(cur.q0), b0 = bflo(cur.q1), b1 = bfhi(cur.q1), c0 = bflo(cur.q2), c1 = bfhi(cur.q2);
          const float rstd = rsqrtf(wave_sum(a0 * a0 + a1 * a1 + b0 * b0 + b1 * b1 + c0 * c0 + c1 * c1) * (1.f / 384.f) + NORM_EPS);
          unsigned* q = (unsigned*)(QN + (size_t)r * 384);
          q[lane] = pk2(a0 * rstd * gq0, a1 * rstd * gq1); q[lane + 64] = pk2(b0 * rstd * gq2, b1 * rstd * gq3); q[lane + 128] = pk2(c0 * rstd * gq4, c1 * rstd * gq5); }
        { float a0 = bflo(cur.k0), a1 = bfhi(cur.k0), b0 = bflo(cur.k1), b1 = bfhi(cur.k1);
          const float rstd = rsqrtf(wave_sum(a0 * a0 + a1 * a1 + b0 * b0 + b1 * b1) * (1.f / 256.f) + NORM_EPS);
          a0 *= rstd * gk0; a1 *= rstd * gk1; b0 *= rstd * gk2; b1 *= rstd * gk3;
          unsigned* k = (unsigned*)(CKV + krow * 256); k[lane] = pk2(a0, a1); k[lane + 64] = pk2(b0, b1);
          if (ctx) { float* o = out_ckv + (size_t)r * 256; __builtin_nontemporal_store((f32x2_t){a0, a1}, (f32x2_t*)(o + 2 * lane)); __builtin_nontemporal_store((f32x2_t){b0, b1}, (f32x2_t*)(o + 2 * lane + 128)); } }
        { float v = bf2f(cur.kr);
          if (ctx) out_kr[(size_t)r * 64 + lane] = v;
          const float p = __shfl_xor(v, 16);
          if (!ctx) { const int pos = (lane < 32) ? (l >> 6) : (l & 63), idx = lane & 15; const float cs = rope[(pos * 16 + idx) * 2], sn = rope[(pos * 16 + idx) * 2 + 1];
              v = (lane & 16) ? (v * cs + p * sn) : (v * cs - p * sn); }
          KR[krow * 64 + lane] = f2bf1(v); }
#pragma unroll
        for (int jj = 0; jj < 2; ++jj) { const int ch = 8 * lane + 512 * jj;
            const f32x4 w0a = *(const f32x4*)(conv_w + ch), w0b = *(const f32x4*)(conv_w + ch + 4);
            const f32x4 w1a = *(const f32x4*)(conv_w + 1024 + ch), w1b = *(const f32x4*)(conv_w + 1024 + ch + 4);
            const f32x4 w2a = *(const f32x4*)(conv_w + 2048 + ch), w2b = *(const f32x4*)(conv_w + 2048 + ch + 4);
            const f32x4 ba = *(const f32x4*)(conv_b + ch), bb = *(const f32x4*)(conv_b + ch + 4);
            float y[8];
#pragma unroll
            for (int e = 0; e < 4; ++e) {
                const unsigned um = cur.m1[jj][e], uc = cur.c0[jj][e], up = cur.p1[jj][e];
                const float wlo0 = (e < 2) ? w0a[2 * e] : w0b[2 * e - 4], whi0 = (e < 2) ? w0a[2 * e + 1] : w0b[2 * e - 3];
                const float wlo1 = (e < 2) ? w1a[2 * e] : w1b[2 * e - 4], whi1 = (e < 2) ? w1a[2 * e + 1] : w1b[2 * e - 3];
                const float wlo2 = (e < 2) ? w2a[2 * e] : w2b[2 * e - 4], whi2 = (e < 2) ? w2a[2 * e + 1] : w2b[2 * e - 3];
                const float blo = (e < 2) ? ba[2 * e] : bb[2 * e - 4], bhi = (e < 2) ? ba[2 * e + 1] : bb[2 * e - 3];
                y[2 * e] = silu_f(blo + bflo(um) * wlo0 + bflo(uc) * wlo1 + bflo(up) * wlo2);
                y[2 * e + 1] = silu_f(bhi + bfhi(um) * whi0 + bfhi(uc) * whi1 + bfhi(up) * whi2);
            }
            u32x4 o; o.x = pk2(y[0], y[1]); o.y = pk2(y[2], y[3]); o.z = pk2(y[4], y[5]); o.w = pk2(y[6], y[7]);
            *(u32x4*)(XS + (size_t)r * 1024 + ch) = o; }
        if (lane < 16) { const float x = cur.dtr + dtb; DT[(size_t)r * 16 + lane] = fmaxf(x, 0.f) + log1pf(__expf(-fabsf(x))); }
        cur = nxt;
    }
}

struct P6Row { u32x4 yf, yb, xs, zz; };
DI void p6_load(P6Row& R, const bf16* YF, const bf16* YB, const bf16* XS, const bf16* Z, int r, int ch) {
    R.yf = *(const u32x4*)(YF + (size_t)r * 512 + ch); R.yb = *(const u32x4*)(YB + (size_t)r * 512 + ch);
    R.xs = *(const u32x4*)(XS + (size_t)r * 1024 + ch); R.zz = *(const u32x4*)(Z + (size_t)r * 512 + ch);
}
DI void phase6(const float* const* in, unsigned char* ws, int G) {
    const int lane = threadIdx.x & 63, wave = threadIdx.x >> 6, gw = blockIdx.x * 8 + wave, NGW = G * 8;
    const bf16* YF = (const bf16*)(ws + WS_YF); const bf16* YB = (const bf16*)(ws + WS_YB); const bf16* XS = (const bf16*)(ws + WS_XS); const bf16* Z = (const bf16*)(ws + WS_Z);
    bf16* MIX = (bf16*)(ws + WS_MIX); const float* d_skip = in[20]; const float* g_out = in[21];
    const int ch = 8 * lane; const float dsk = d_skip[lane >> 3];
    const f32x4 g0 = *(const f32x4*)(g_out + ch), g1 = *(const f32x4*)(g_out + ch + 4);
    P6Row cur, nxt;
    if (gw < NTOK) p6_load(cur, YF, YB, XS, Z, gw, ch);
    for (int r = gw; r < NTOK; r += NGW) {
        if (r + NGW < NTOK) p6_load(nxt, YF, YB, XS, Z, r + NGW, ch);
        float y[8]; float s = 0.f;
#pragma unroll
        for (int e = 0; e < 4; ++e) {
            const float ylo = bflo(cur.yf[e]) + bflo(cur.yb[e]) + dsk * bflo(cur.xs[e]);
            const float yhi = bfhi(cur.yf[e]) + bfhi(cur.yb[e]) + dsk * bfhi(cur.xs[e]);
            y[2 * e] = ylo * silu_f(bflo(cur.zz[e])); y[2 * e + 1] = yhi * silu_f(bfhi(cur.zz[e]));
            s += y[2 * e] * y[2 * e] + y[2 * e + 1] * y[2 * e + 1];
        }
        const float rstd = rsqrtf(wave_sum(s) * (1.f / 512.f) + NORM_EPS);
        u32x4 o; o.x = pk2(y[0] * rstd * g0[0], y[1] * rstd * g0[1]); o.y = pk2(y[2] * rstd * g0[2], y[3] * rstd * g0[3]);
        o.z = pk2(y[4] * rstd * g1[0], y[5] * rstd * g1[1]); o.w = pk2(y[6] * rstd * g1[2], y[7] * rstd * g1[3]);
        *(u32x4*)(MIX + (size_t)r * 1024 + 512 + ch) = o;
        cur = nxt;
    }
}

DI void phase8(const float* const* in, float* out, unsigned char* ws, int G) {
    const int lane = threadIdx.x & 63, wave = threadIdx.x >> 6, gw = blockIdx.x * 8 + wave, NGW = G * 8;
    const float* mod = (const float*)(ws + WS_MOD); const float* OM = (const float*)(ws + WS_OM); bf16* H = (bf16*)(ws + WS_H);
    const float* g_post = in[10]; const float* g_pre = in[23];
    for (int r = gw; r < NTOK; r += NGW) {
        const f32x4* xr = (const f32x4*)xrow_ptr(in, r) + lane; const f32x4* om = (const f32x4*)(OM + (size_t)r * DM) + lane; const float* mj = mod + mod_idx(r) * 6144;
        f32x4 v[4], y[4]; float s = 0.f;
#pragma unroll
        for (int j = 0; j < 4; ++j) { v[j] = om[64 * j]; s += v[j].x * v[j].x + v[j].y * v[j].y + v[j].z * v[j].z + v[j].w * v[j].w; }
        const float rstd = rsqrtf(wave_sum(s) * (1.f / DM) + NORM_EPS);
        float s2 = 0.f;
#pragma unroll
        for (int j = 0; j < 4; ++j) { const int k = 4 * lane + 256 * j;
            const f32x4 g = *(const f32x4*)(g_post + k), gt = *(const f32x4*)(mj + 2048 + k);
            y[j] = xr[64 * j] + gt * (v[j] * rstd * g);
            s2 += y[j].x * y[j].x + y[j].y * y[j].y + y[j].z * y[j].z + y[j].w * y[j].w;
            *((f32x4*)(out + (size_t)r * DM) + lane + 64 * j) = y[j]; }
        const float rstd2 = rsqrtf(wave_sum(s2) * (1.f / DM) + NORM_EPS);
        u32x2* o = (u32x2*)(H + (size_t)r * DM) + lane;
#pragma unroll
        for (int j = 0; j < 4; ++j) { const int k = 4 * lane + 256 * j;
            const f32x4 g = *(const f32x4*)(g_pre + k), sc = *(const f32x4*)(mj + 4096 + k), sh = *(const f32x4*)(mj + 3072 + k);
            const f32x4 h = y[j] * rstd2 * g * (sc + 1.f) + sh;
            u32x2 w; w.x = pk2(h.x, h.y); w.y = pk2(h.z, h.w); o[64 * j] = w; }
    }
}

DI void phase11(const float* const* in, float* out, unsigned char* ws, int G) {
    const int lane = threadIdx.x & 63, wave = threadIdx.x >> 6, gw = blockIdx.x * 8 + wave, NGW = G * 8;
    const float* mod = (const float*)(ws + WS_MOD); const float* F = (const float*)(ws + WS_F); const float* g_post = in[24];
    for (int r = gw; r < NTOK; r += NGW) {
        const f32x4* fr = (const f32x4*)(F + (size_t)r * DM) + lane; const float* mj = mod + mod_idx(r) * 6144;
        f32x4 v[4]; float s = 0.f;
#pragma unroll
        for (int j = 0; j < 4; ++j) { v[j] = fr[64 * j]; s += v[j].x * v[j].x + v[j].y * v[j].y + v[j].z * v[j].z + v[j].w * v[j].w; }
        const float rstd = rsqrtf(wave_sum(s) * (1.f / DM) + NORM_EPS);
#pragma unroll
        for (int j = 0; j < 4; ++j) { const int k = 4 * lane + 256 * j;
            const f32x4 g = *(const f32x4*)(g_post + k), gt = *(const f32x4*)(mj + 5120 + k);
            f32x4* o = (f32x4*)(out + (size_t)r * DM) + lane + 64 * j;
            *o = *o + gt * (v[j] * rstd * g); }
    }
}

constexpr int AK_STRIDE = 400, AV_STRIDE = 144, AV_OFF = 64 * AK_STRIDE, A_STAGE = AV_OFF + 128 * AV_STRIDE;
DI void attn_unit(LAS unsigned char* lds, const bf16* Q, const bf16* KN, const bf16* KR, const bf16* VT, bf16* MIX, const float* rope, int qrow0, int krow0, int nkt, int hh) {
    const int tid = threadIdx.x, lane = tid & 63, wave = tid >> 6, rg = wave & 3, kh = wave >> 2, r = lane & 31, hf = lane >> 5;
    bf16x8 qf[12];
    { const bf16* qp = Q + (size_t)(qrow0 + 32 * rg + r) * 768 + hh * 192 + 8 * hf;
#pragma unroll
      for (int ks = 0; ks < 12; ++ks) qf[ks] = *(const bf16x8*)(qp + 16 * ks); }
    if (rope) {
        const int l = (qrow0 + 32 * rg + r - NCTX) & 1023;
#pragma unroll
        for (int hfi = 0; hfi < 2; ++hfi) {
            const int pos = hfi ? (l & 63) : (l >> 6);
            const float* t = rope + (pos * 16 + 8 * hf) * 2;
            const u32x4 a = __builtin_bit_cast(u32x4, qf[8 + 2 * hfi]), b = __builtin_bit_cast(u32x4, qf[9 + 2 * hfi]); u32x4 ao, bo;
#pragma unroll
            for (int e = 0; e < 4; ++e) {
                const float x1l = bflo(a[e]), x1h = bfhi(a[e]), x2l = bflo(b[e]), x2h = bfhi(b[e]);
                const float c0 = t[4 * e], s0 = t[4 * e + 1], c1 = t[4 * e + 2], s1 = t[4 * e + 3];
                ao[e] = pk2(x1l * c0 - x2l * s0, x1h * c1 - x2h * s1);
                bo[e] = pk2(x2l * c0 + x1l * s0, x2h * c1 + x1h * s1);
            }
            qf[8 + 2 * hfi] = __builtin_bit_cast(bf16x8, ao); qf[9 + 2 * hfi] = __builtin_bit_cast(bf16x8, bo);
        }
    }
    f32x16 o[4];
#pragma unroll
    for (int d = 0; d < 4; ++d)
#pragma unroll
        for (int i = 0; i < 16; ++i) o[d][i] = 0.f;
    float mrun = -1e30f, lsum = 0.f;
    const int skey = tid >> 3, ssub = tid & 7, sd = tid >> 2, svs = tid & 3;
    const bf16* knp = KN + (size_t)(krow0 + skey) * 512 + hh * 128 + ssub * 8;
    const bf16* krp = KR + (size_t)(krow0 + skey) * 64 + ssub * 8;
    const bf16* vtp = VT + (size_t)(hh * 128 + sd) * NKROW + krow0 + svs * 8;
    const unsigned kdst0 = skey * AK_STRIDE + ssub * 16, vdst0 = AV_OFF + sd * AV_STRIDE + svs * 16;
    u32x4 pk[3], pv[2];
#define ATT_LOAD(kt_) do { const bf16* a_ = knp + (size_t)(kt_) * (64 * 512); pk[0] = *(const u32x4*)a_; pk[1] = *(const u32x4*)(a_ + 64); pk[2] = *(const u32x4*)(krp + (size_t)(kt_) * (64 * 64)); \
                           const bf16* v_ = vtp + (kt_) * 64; pv[0] = *(const u32x4*)v_; pv[1] = *(const u32x4*)(v_ + 32); } while (0)
#define ATT_WRITE(st_) do { LAS unsigned char* b_ = lds + (st_) * A_STAGE; *(LAS u32x4*)(b_ + kdst0) = pk[0]; *(LAS u32x4*)(b_ + kdst0 + 128) = pk[1]; *(LAS u32x4*)(b_ + kdst0 + 256) = pk[2]; \
                            *(LAS u32x4*)(b_ + vdst0) = pv[0]; *(LAS u32x4*)(b_ + vdst0 + 64) = pv[1]; } while (0)
    __syncthreads();
    ATT_LOAD(0); ATT_WRITE(0);
    if (nkt > 1) ATT_LOAD(1);
    __syncthreads();
    for (int kt = 0; kt < nkt; ++kt) {
        const int cur = kt & 1;
        if (kt + 1 < nkt) { ATT_WRITE(cur ^ 1); if (kt + 2 < nkt) ATT_LOAD(kt + 2); }
        const LAS unsigned char* stg = lds + cur * A_STAGE;
        f32x16 s;
#pragma unroll
        for (int i = 0; i < 16; ++i) s[i] = 0.f;
        {
            const LAS unsigned char* kp = stg + (32 * kh + r) * AK_STRIDE + 16 * hf;
            bf16x8 ka[4], kb[4];
#pragma unroll
            for (int i = 0; i < 4; ++i) ka[i] = *(const LAS bf16x8*)(kp + 32 * i);
#pragma unroll
            for (int i = 0; i < 4; ++i) kb[i] = *(const LAS bf16x8*)(kp + 32 * (4 + i));
            __builtin_amdgcn_sched_barrier(0);
#pragma unroll
            for (int i = 0; i < 4; ++i) s = MFMA32(ka[i], qf[i], s);
#pragma unroll
            for (int i = 0; i < 4; ++i) ka[i] = *(const LAS bf16x8*)(kp + 32 * (8 + i));
            __builtin_amdgcn_sched_barrier(0);
#pragma unroll
            for (int i = 0; i < 4; ++i) s = MFMA32(kb[i], qf[4 + i], s);
#pragma unroll
            for (int i = 0; i < 4; ++i) s = MFMA32(ka[i], qf[8 + i], s);
        }
        const LAS unsigned char* vbase = stg + AV_OFF + r * AV_STRIDE + (32 * kh + 4 * hf) * 2;
        s16x4 vlo[4], vhi[4];
#pragma unroll
        for (int d = 0; d < 4; ++d) { vlo[d] = *(const LAS s16x4*)(vbase + 32 * d * AV_STRIDE); vhi[d] = *(const LAS s16x4*)(vbase + 32 * d * AV_STRIDE + 16); }
        __builtin_amdgcn_sched_barrier(0);
        float mx = s[0];
#pragma unroll
        for (int i = 1; i < 16; ++i) mx = fmaxf(mx, s[i]);
        mx = fmaxf(mx, __shfl_xor(mx, 32));
        const float mnew = fmaxf(mrun, mx), alpha = __builtin_amdgcn_exp2f(mrun - mnew); mrun = mnew;
        float ps = 0.f;
#pragma unroll
        for (int i = 0; i < 16; ++i) { s[i] = __builtin_amdgcn_exp2f(s[i] - mnew); ps += s[i]; }
        lsum = lsum * alpha + ps;
#pragma unroll
        for (int d = 0; d < 4; ++d)
#pragma unroll
            for (int i = 0; i < 16; ++i) o[d][i] *= alpha;
        {
            u32x4 pw; pw.x = pk2(s[0], s[1]); pw.y = pk2(s[2], s[3]); pw.z = pk2(s[4], s[5]); pw.w = pk2(s[6], s[7]);
            const bf16x8 pf = __builtin_bit_cast(bf16x8, pw);
            bf16x8 vf[4];
#pragma unroll
            for (int d = 0; d < 4; ++d) vf[d] = __builtin_shufflevector(vlo[d], vhi[d], 0, 1, 2, 3, 4, 5, 6, 7);
#pragma unroll
            for (int d = 0; d < 4; ++d) { vlo[d] = *(const LAS s16x4*)(vbase + 32 * d * AV_STRIDE + 32); vhi[d] = *(const LAS s16x4*)(vbase + 32 * d * AV_STRIDE + 48); }
            __builtin_amdgcn_sched_barrier(0);
#pragma unroll
            for (int d = 0; d < 4; ++d) o[d] = MFMA32(vf[d], pf, o[d]);
        }
        {
            u32x4 pw; pw.x = pk2(s[8], s[9]); pw.y = pk2(s[10], s[11]); pw.z = pk2(s[12], s[13]); pw.w = pk2(s[14], s[15]);
            const bf16x8 pf = __builtin_bit_cast(bf16x8, pw);
#pragma unroll
            for (int d = 0; d < 4; ++d) { const bf16x8 vf = __builtin_shufflevector(vlo[d], vhi[d], 0, 1, 2, 3, 4, 5, 6, 7); o[d] = MFMA32(vf, pf, o[d]); }
        }
        __syncthreads();
    }
#undef ATT_LOAD
#undef ATT_WRITE
    lsum += __shfl_xor(lsum, 32);
    LAS float* Mg = (LAS float*)lds + rg * 4096; LAS float* ml = (LAS float*)(lds + 65536) + rg * 128;
    if (kh == 1) {
#pragma unroll
        for (int d = 0; d < 4; ++d)
#pragma unroll
            for (int i = 0; i < 16; ++i) Mg[(d * 16 + i) * 64 + lane] = o[d][i];
        ml[lane] = mrun; ml[64 + lane] = lsum;
    }
    __syncthreads();
    if (kh == 0) {
        const float m1 = ml[lane], l1 = ml[64 + lane], m = fmaxf(mrun, m1), a0 = __builtin_amdgcn_exp2f(mrun - m), a1 = __builtin_amdgcn_exp2f(m1 - m);
        const float inv = 1.f / (lsum * a0 + l1 * a1), w0 = a0 * inv, w1 = a1 * inv;
        bf16* op = MIX + (size_t)(qrow0 + 32 * rg + r) * 1024 + hh * 128 + 4 * hf;
#pragma unroll
        for (int d = 0; d < 4; ++d)
#pragma unroll
            for (int ig = 0; ig < 4; ++ig) { float v[4];
#pragma unroll
                for (int e = 0; e < 4; ++e) v[e] = o[d][4 * ig + e] * w0 + Mg[(d * 16 + 4 * ig + e) * 64 + lane] * w1;
                u32x2 w; w.x = pk2(v[0], v[1]); w.y = pk2(v[2], v[3]); *(u32x2*)(op + 32 * d + 8 * ig) = w; }
    }
}

constexpr int SS = 272;
constexpr int S_BS = 0, S_CS = 34816, S_BT = 69632, S_XT = 104448, S_SB = 121856, S_ACS = 139264, S_DT = 139776;
DI void ssd_item(LAS unsigned char* lds, const bf16* XS, const float* DT, const float* a_log, const float* st_in, float* st_out, bf16* Y, int row0, int L, int h, int dir) {
    const int tid = threadIdx.x, lane = tid & 63, wave = tid >> 6, r = lane & 31, hf = lane >> 5, pt = wave & 1, lt = (wave < 4) ? (wave >> 1) : (3 - ((wave - 4) >> 1));
    const int grp = h >> 2;
    const float a = -expf(a_log[dir * 8 + h]);
    LAS float* acs = (LAS float*)(lds + S_ACS); LAS float* dts = (LAS float*)(lds + S_DT);
    f32x16 S;
#pragma unroll
    for (int i = 0; i < 16; ++i) S[i] = st_in ? st_in[(size_t)(32 * pt + crow(i, hf)) * 128 + 32 * lt + r] : 0.f;
    const int nch = L >> 7;
    u32x4 vb[4], vc[4], vx[2]; float d0 = 0.f, d1 = 0.f;
    const int pcol = tid & 15, prow = tid >> 4, xcol = tid & 7, xrow = tid >> 3;
#define SSD_LOAD(ch_) do { \
        _Pragma("unroll") for (int k = 0; k < 4; ++k) { const int i0 = 128 * (ch_) + prow + 32 * k, t = dir ? (L - 1 - i0) : i0; \
            const bf16* rpb = XS + (size_t)(row0 + t) * 1024 + 512 + grp * 128 + 8 * pcol; vb[k] = *(const u32x4*)rpb; vc[k] = *(const u32x4*)(rpb + 256); } \
        _Pragma("unroll") for (int k = 0; k < 2; ++k) { const int i0 = 128 * (ch_) + xrow + 64 * k, t = dir ? (L - 1 - i0) : i0; \
            vx[k] = *(const u32x4*)(XS + (size_t)(row0 + t) * 1024 + h * 64 + 8 * xcol); } \
        if (wave == 0) { const int i0 = 128 * (ch_) + 2 * lane, t0 = dir ? (L - 1 - i0) : i0, t1 = dir ? (t0 - 1) : (t0 + 1); \
            d0 = DT[(size_t)(row0 + t0) * 16 + dir * 8 + h]; d1 = DT[(size_t)(row0 + t1) * 16 + dir * 8 + h]; } } while (0)
    for (int ch = 0; ch < nch; ++ch) {
        SSD_LOAD(ch);
        __syncthreads();
        if (wave == 0) {
            const float x0 = d0 * a, x1 = d1 * a; float v = x0 + x1;
#pragma unroll
            for (int o = 1; o < 64; o <<= 1) { const float n = __shfl_up(v, o); if (lane >= o) v += n; }
            acs[2 * lane] = v - x1; acs[2 * lane + 1] = v; dts[2 * lane] = d0; dts[2 * lane + 1] = d1;
        }
#pragma unroll
        for (int i = 0; i < 16; ++i) *(LAS unsigned short*)(lds + S_SB + (32 * pt + crow(i, hf)) * SS + (32 * lt + r) * 2) = f2bf1(S[i]);
        __syncthreads();
        const float acs_last = acs[127];
#pragma unroll
        for (int k = 0; k < 4; ++k) { const int l = prow + 32 * k;
            *(LAS u32x4*)(lds + S_BS + l * SS + pcol * 16) = vb[k]; *(LAS u32x4*)(lds + S_CS + l * SS + pcol * 16) = vc[k];
            const float wB = __expf(acs_last - acs[l]);
            LAS unsigned char* colb = lds + S_BT + (8 * pcol) * SS + ((((l >> 3) ^ pcol) << 3) + (l & 7)) * 2;
#pragma unroll
            for (int e = 0; e < 4; ++e) { const unsigned u = pk2(bflo(vb[k][e]) * wB, bfhi(vb[k][e]) * wB);
                *(LAS unsigned short*)(colb + (2 * e) * SS) = (unsigned short)(u & 0xffffu);
                *(LAS unsigned short*)(colb + (2 * e + 1) * SS) = (unsigned short)(u >> 16); } }
#pragma unroll
        for (int k = 0; k < 2; ++k) { const int l = xrow + 64 * k; const float wX = dts[l];
            LAS unsigned char* colb = lds + S_XT + (8 * xcol) * SS + ((((l >> 3) ^ xcol) << 3) + (l & 7)) * 2;
#pragma unroll
            for (int e = 0; e < 4; ++e) { const unsigned u = pk2(bflo(vx[k][e]) * wX, bfhi(vx[k][e]) * wX);
                *(LAS unsigned short*)(colb + (2 * e) * SS) = (unsigned short)(u & 0xffffu);
                *(LAS unsigned short*)(colb + (2 * e + 1) * SS) = (unsigned short)(u >> 16); } }
        __syncthreads();
        bf16x8 cf[8];
#pragma unroll
        for (int ks = 0; ks < 8; ++ks) cf[ks] = *(const LAS bf16x8*)(lds + S_CS + (32 * lt + r) * SS + (16 * ks + 8 * hf) * 2);
        const float acs_l = acs[32 * lt + r]; const int lcol = 32 * lt + r;
        const int cX = (4 * pt + (r >> 3)) & 7, cB = (4 * lt + (r >> 3)) & 15;
        f32x16 Yd;
#pragma unroll
        for (int i = 0; i < 16; ++i) Yd[i] = 0.f;
        for (int st = 0; st <= lt; ++st) {
            f32x16 cb;
#pragma unroll
            for (int i = 0; i < 16; ++i) cb[i] = 0.f;
            { bf16x8 bfr[8]; const LAS unsigned char* bp = lds + S_BS + (32 * st + r) * SS + 16 * hf;
#pragma unroll
              for (int ks = 0; ks < 8; ++ks) bfr[ks] = *(const LAS bf16x8*)(bp + 32 * ks);
              __builtin_amdgcn_sched_barrier(0);
#pragma unroll
              for (int ks = 0; ks < 8; ++ks) cb = MFMA32(bfr[ks], cf[ks], cb); }
            s16x4 xlo[2], xhi[2]; float av[16];
#pragma unroll
            for (int u = 0; u < 2; ++u) { const LAS unsigned char* xp = lds + S_XT + (32 * pt + r) * SS + 8 * hf; const int lg = 4 * st + 2 * u;
                xlo[u] = *(const LAS s16x4*)(xp + ((lg ^ cX) << 4)); xhi[u] = *(const LAS s16x4*)(xp + (((lg + 1) ^ cX) << 4)); }
#pragma unroll
            for (int i = 0; i < 16; ++i) av[i] = acs[32 * st + crow(i, hf)];
#pragma unroll
            for (int i = 0; i < 16; ++i) { const int sidx = 32 * st + crow(i, hf); const float e = __expf(acs_l - av[i]); cb[i] = (sidx <= lcol) ? cb[i] * e : 0.f; }
#pragma unroll
            for (int u = 0; u < 2; ++u) {
                u32x4 pw; pw.x = pk2(cb[8 * u], cb[8 * u + 1]); pw.y = pk2(cb[8 * u + 2], cb[8 * u + 3]); pw.z = pk2(cb[8 * u + 4], cb[8 * u + 5]); pw.w = pk2(cb[8 * u + 6], cb[8 * u + 7]);
                const bf16x8 pf = __builtin_bit_cast(bf16x8, pw);
                const bf16x8 xa = __builtin_shufflevector(xlo[u], xhi[u], 0, 1, 2, 3, 4, 5, 6, 7);
                Yd = MFMA32(xa, pf, Yd);
            }
        }
        f32x16 Yo;
#pragma unroll
        for (int i = 0; i < 16; ++i) Yo[i] = 0.f;
        { bf16x8 sa[8]; const LAS unsigned char* sp = lds + S_SB + (32 * pt + r) * SS + 16 * hf;
#pragma unroll
          for (int ks = 0; ks < 8; ++ks) sa[ks] = *(const LAS bf16x8*)(sp + 32 * ks);
          __builtin_amdgcn_sched_barrier(0);
#pragma unroll
          for (int ks = 0; ks < 8; ++ks) Yo = MFMA32(sa[ks], cf[ks], Yo); }
        { const float el = __expf(acs_l); const int i0 = 128 * ch + lcol, t = dir ? (L - 1 - i0) : i0;
          bf16* yp = Y + (size_t)(row0 + t) * 512 + h * 64 + 32 * pt + 4 * hf;
#pragma unroll
          for (int ig = 0; ig < 4; ++ig) { u32x2 v; v.x = pk2(Yd[4 * ig] + el * Yo[4 * ig], Yd[4 * ig + 1] + el * Yo[4 * ig + 1]); v.y = pk2(Yd[4 * ig + 2] + el * Yo[4 * ig + 2], Yd[4 * ig + 3] + el * Yo[4 * ig + 3]);
              *(u32x2*)(yp + 8 * ig) = v; } }
        { const float dl = __expf(acs_last);
#pragma unroll
          for (int i = 0; i < 16; ++i) S[i] *= dl;
          const LAS unsigned char* xp2 = lds + S_XT + (32 * pt + r) * SS; const LAS unsigned char* bp2 = lds + S_BT + (32 * lt + r) * SS;
#pragma unroll
          for (int half = 0; half < 2; ++half) { bf16x8 xa[4], bb[4];
#pragma unroll
              for (int k = 0; k < 4; ++k) { const int lg = 2 * (4 * half + k) + hf; xa[k] = *(const LAS bf16x8*)(xp2 + ((lg ^ cX) << 4)); bb[k] = *(const LAS bf16x8*)(bp2 + ((lg ^ cB) << 4)); }
              __builtin_amdgcn_sched_barrier(0);
#pragma unroll
              for (int k = 0; k < 4; ++k) S = MFMA32(xa[k], bb[k], S); } }
    }
#undef SSD_LOAD
    if (st_out) {
#pragma unroll
        for (int i = 0; i < 16; ++i) st_out[(size_t)(32 * pt + crow(i, hf)) * 128 + 32 * lt + r] = S[i];
    }
}

DI void phase5(LAS unsigned char* lds, const float* const* in, float* out, unsigned char* ws, int G) {
    const bf16* Q = (const bf16*)(ws + WS_Q); const bf16* KN = (const bf16*)(ws + WS_KN); const bf16* KR = (const bf16*)(ws + WS_KR); const bf16* VT = (const bf16*)(ws + WS_VT);
    bf16* MIX = (bf16*)(ws + WS_MIX);
    const int bxl = (int)blockIdx.x, vb = (G == 256) ? ((bxl & 7) * 32 + (bxl >> 3)) : bxl;
    for (int u = vb; u < 512; u += G) {
        if (u < 256) { const int b = u >> 5, hh = (u >> 3) & 3, qb = u & 7; attn_unit(lds, Q, KN, KR, VT, MIX, (const float*)(ws + WS_ROPE), NCTX + b * 1024 + qb * 128, NCTX + b * 1280, 20, hh); }
        else { const int v = u - 256, b = v >> 3, hh = (v >> 1) & 3, qb = v & 1; attn_unit(lds, Q, KN, KR, VT, MIX, nullptr, b * 256 + qb * 128, b * 256, 4, hh); }
    }
    const bf16* XS = (const bf16*)(ws + WS_XS); const float* DT = (const float*)(ws + WS_DT); const float* a_log = in[19];
    bf16* YF = (bf16*)(ws + WS_YF); bf16* YB = (bf16*)(ws + WS_YB);
    float* out_st = out + 2 * (size_t)NCTX * DM + (size_t)NCTX * 256 + (size_t)NCTX * 64;
    const int vs = (G == 256) ? (((bxl >> 3) < 16) ? ((bxl & 7) * 16 + (bxl >> 3)) : (128 + (bxl & 7) * 16 + (bxl >> 3) - 16)) : bxl;
    for (int s = vs; s < 256; s += G) {
        if (s < 128) { const int b = s >> 4, h = (s >> 1) & 7, dir = s & 1;
            ssd_item(lds, XS, DT, a_log, in[4] + ((size_t)(b * 2 + dir) * 8 + h) * 8192, nullptr, dir ? YB : YF, NCTX + b * 1024, 1024, h, dir); }
        else { for (int k = 0; k < 4; ++k) { const int it = (s - 128) * 4 + k, b = it >> 4, h = (it >> 1) & 7, dir = it & 1;
            ssd_item(lds, XS, DT, a_log, nullptr, out_st + ((size_t)(b * 2 + dir) * 8 + h) * 8192, dir ? YB : YF, b * 256, 256, h, dir); } }
    }
}

#define XB_TMO      128
#define XB_XCNT(j)  (256  + 64 * (j))
#define XB_XSUB(j)  (1280 + 64 * (j))
#define XB_XGEN(j)  (2304 + 64 * (j))
#define XB_TOP      3328
#define XB_TOPGEN   3392
#define XCD_BAR_WORDS 3456
#define XB_SPIN_CAP (1u << 18)
__device__ __forceinline__ unsigned xb_ld(unsigned* p)              { return __hip_atomic_load(p, __ATOMIC_RELAXED, __HIP_MEMORY_SCOPE_AGENT); }
__device__ __forceinline__ unsigned xb_add(unsigned* p, unsigned v) { return __hip_atomic_fetch_add(p, v, __ATOMIC_RELAXED, __HIP_MEMORY_SCOPE_AGENT); }
__device__ __forceinline__ unsigned xb_xcc_id() { return (unsigned)__builtin_amdgcn_s_getreg((3 << 11) | 20) & 0xFu; }
#define XB_SPIN(cond, bar) do { unsigned _sp = 0; while (cond) { __builtin_amdgcn_s_sleep(1); \
    if ((++_sp & 255u) == 0u) { if (xb_ld(&(bar)[XB_TMO])) break; if (_sp > XB_SPIN_CAP) { atomicAdd(&(bar)[XB_TMO], 1u); break; } } } } while (0)
struct XcdBarrier { unsigned* bar; unsigned x; volatile LAS unsigned* st; };
__device__ __forceinline__ XcdBarrier xcd_barrier_post(unsigned* bar, volatile LAS unsigned* st) {
    XcdBarrier b; b.bar = bar; b.x = xb_xcc_id(); b.st = st;
    if (threadIdx.x == 0) (void)xb_add(&bar[XB_XCNT(b.x)], 1u);
    return b;
}
__device__ __forceinline__ void xcd_barrier_complete(unsigned* bar, unsigned x, unsigned& nloc, unsigned& nx) {
    const unsigned G = gridDim.x * gridDim.y * gridDim.z;
    unsigned sum, cnt, mine, sp = 0u;
    for (;;) {
        sum = 0u; cnt = 0u; mine = 0u;
#pragma unroll
        for (unsigned j = 0; j < 16; ++j) { const unsigned c = xb_ld(&bar[XB_XCNT(j)]); sum += c; cnt += (c > 0u) ? 1u : 0u; mine = (j == x) ? c : mine; }
        if (sum == G) break;
        __builtin_amdgcn_s_sleep(1);
        if ((++sp & 255u) == 0u) { if (xb_ld(&bar[XB_TMO])) break; if (sp > XB_SPIN_CAP) { atomicAdd(&bar[XB_TMO], 1u); break; } }
    }
    nloc = mine > 0u ? mine : 1u; nx = cnt > 0u ? cnt : 1u;
}
__device__ __forceinline__ void xcd_barrier(const XcdBarrier& b) {
    asm volatile("s_waitcnt vmcnt(0)" ::: "memory");
    __syncthreads();
    if (threadIdx.x == 0) {
        unsigned* bar = b.bar;
        __builtin_amdgcn_s_waitcnt(0);
        unsigned nloc = b.st[0], nx = b.st[1];
        if (nloc == 0u) { xcd_barrier_complete(bar, b.x, nloc, nx); b.st[0] = nloc; b.st[1] = nx; }
        const unsigned old = xb_add(&bar[XB_XSUB(b.x)], 1u);
        const unsigned gen = old / nloc;
        if (old + 1u == (gen + 1u) * nloc) {
            __builtin_amdgcn_fence(__ATOMIC_RELEASE, "agent");
            asm volatile("s_waitcnt vmcnt(0)" ::: "memory");
            const unsigned og = xb_add(&bar[XB_TOP], 1u);
            const unsigned tg = og / nx;
            if (og + 1u == (tg + 1u) * nx) xb_add(&bar[XB_TOPGEN], 1u);
            else XB_SPIN(xb_ld(&bar[XB_TOPGEN]) == tg, bar);
            __builtin_amdgcn_fence(__ATOMIC_ACQUIRE, "agent");
            xb_add(&bar[XB_XGEN(b.x)], 1u);
            asm volatile("s_waitcnt vmcnt(0)" ::: "memory");
        } else {
            XB_SPIN(xb_ld(&bar[XB_XGEN(b.x)]) == gen, bar);
            __builtin_amdgcn_fence(__ATOMIC_ACQUIRE, "agent");
            asm volatile("s_waitcnt vmcnt(0)" ::: "memory");
        }
    }
    __syncthreads();
}
constexpr int LDS_BAR_OFF = 147392;
constexpr size_t CTL_ZERO_BYTES = 65536;

constexpr size_t WS_PS1 = 128 * 1024, WS_PS2 = 384 * 1024, WS_PS3 = 640 * 1024;
DI void panel_sumsq(const f32x4 (&acc)[2][2][4][2], LAS float* red, float* PS, const pg8::Unit& u, int wr, int wc, int fr, int fq) {
#pragma unroll
    for (int ai = 0; ai < 2; ++ai)
#pragma unroll
        for (int m = 0; m < 4; ++m) { float s = 0.f;
#pragma unroll
            for (int bj = 0; bj < 2; ++bj)
#pragma unroll
                for (int n = 0; n < 2; ++n)
#pragma unroll
                    for (int i = 0; i < 4; ++i) s += acc[ai][bj][m][n][i] * acc[ai][bj][m][n][i];
            s += __shfl_xor(s, 16); s += __shfl_xor(s, 32);
            if (fq == 0) red[wc * 256 + ai * 128 + wr * 64 + m * 16 + fr] = s; }
    __syncthreads();
    if (threadIdx.x < 256) { const int t = threadIdx.x; PS[u.pn * NTOK + u.pm * 256 + t] = red[t] + red[256 + t] + red[512 + t] + red[768 + t]; }
}
DI void panel_rstd(LAS float* rs, const float* PS, const pg8::Unit& u) {
    if (threadIdx.x < 256) { const int row = u.pm * 256 + threadIdx.x; rs[threadIdx.x] = rsqrtf((PS[row] + PS[NTOK + row] + PS[2 * NTOK + row] + PS[3 * NTOK + row]) * (1.f / DM) + NORM_EPS); }
    __syncthreads();
}
struct EpiMixFused {
    static constexpr bool PERM = true, AFTER_DRAIN = true;
    const float* x0; const float* x1; bf16* Y1; bf16* H; const float* mod; const float* g_post; const float* g_pre; float* PS1; float* PS2; XcdBarrier bar;
    DI void operator()(const f32x4 (&)[2][2][4][2], const pg8::Unit&, int, int, int, int) const {}
    DI void fused(f32x4 (&acc)[2][2][4][2], const pg8::Unit& u, int wr, int wc, int fr, int fq, LAS unsigned char* lds, int wid, int lane) const {
        LAS float* red = (LAS float*)lds; LAS float* rs = (LAS float*)(lds + 4096);
        const int row0 = u.pm * 256 + wr * 64 + fr, col0 = u.pn * 256 + wc * 32 + 8 * fq;
        const float* mj = mod + mod_idx(u.pm * 256) * 6144;
        panel_sumsq(acc, red, PS1, u, wr, wc, fr, fq);
        xcd_barrier(bar);
        panel_rstd(rs, PS1, u);
#pragma unroll
        for (int bj = 0; bj < 2; ++bj) { const int col = col0 + bj * 128;
            const f32x4 ca = *(const f32x4*)(mj + 2048 + col) * *(const f32x4*)(g_post + col), cb = *(const f32x4*)(mj + 2048 + col + 4) * *(const f32x4*)(g_post + col + 4);
#pragma unroll
            for (int ai = 0; ai < 2; ++ai)
#pragma unroll
                for (int m = 0; m < 4; ++m) { const int row = row0 + ai * 128 + m * 16; const float r = rs[ai * 128 + wr * 64 + m * 16 + fr];
                    const float* xr = ((row < NCTX) ? x0 + (size_t)row * DM : x1 + (size_t)(row - NCTX) * DM) + col;
                    const f32x4 y0 = __builtin_nontemporal_load((const f32x4*)xr) + ca * (acc[ai][bj][m][0] * r), y1 = __builtin_nontemporal_load((const f32x4*)(xr + 4)) + cb * (acc[ai][bj][m][1] * r);
                    acc[ai][bj][m][0] = y0; acc[ai][bj][m][1] = y1;
                    st8bf(Y1 + (size_t)row * DM + col, y0, y1); } }
        panel_sumsq(acc, red, PS2, u, wr, wc, fr, fq);
        xcd_barrier(bar);
        panel_rstd(rs, PS2, u);
#pragma unroll
        for (int bj = 0; bj < 2; ++bj) { const int col = col0 + bj * 128;
            const f32x4 ga = *(const f32x4*)(g_pre + col) * (*(const f32x4*)(mj + 4096 + col) + 1.f), gb = *(const f32x4*)(g_pre + col + 4) * (*(const f32x4*)(mj + 4096 + col + 4) + 1.f);
            const f32x4 sa = *(const f32x4*)(mj + 3072 + col), sb = *(const f32x4*)(mj + 3072 + col + 4);
#pragma unroll
            for (int ai = 0; ai < 2; ++ai)
#pragma unroll
                for (int m = 0; m < 4; ++m) { const int row = row0 + ai * 128 + m * 16; const float r = rs[ai * 128 + wr * 64 + m * 16 + fr];
                    st8bf(H + (size_t)row * DM + col, acc[ai][bj][m][0] * r * ga + sa, acc[ai][bj][m][1] * r * gb + sb); } }
    }
};
struct EpiFfnFused {
    static constexpr bool PERM = true, AFTER_DRAIN = true;
    float* out; const bf16* Y1; const float* mod; const float* g_post; float* PS; XcdBarrier bar;
    DI void operator()(const f32x4 (&)[2][2][4][2], const pg8::Unit&, int, int, int, int) const {}
    DI void fused(f32x4 (&acc)[2][2][4][2], const pg8::Unit& u, int wr, int wc, int fr, int fq, LAS unsigned char* lds, int wid, int lane) const {
        LAS float* red = (LAS float*)lds; LAS float* rs = (LAS float*)(lds + 4096);
        const int row0 = u.pm * 256 + wr * 64 + fr, col0 = u.pn * 256 + wc * 32 + 8 * fq;
        const float* mj = mod + mod_idx(u.pm * 256) * 6144;
        panel_sumsq(acc, red, PS, u, wr, wc, fr, fq);
        xcd_barrier(bar);
        panel_rstd(rs, PS, u);
#pragma unroll
        for (int bj = 0; bj < 2; ++bj) { const int col = col0 + bj * 128;
            const f32x4 ca = *(const f32x4*)(mj + 5120 + col) * *(const f32x4*)(g_post + col), cb = *(const f32x4*)(mj + 5120 + col + 4) * *(const f32x4*)(g_post + col + 4);
#pragma unroll
            for (int ai = 0; ai < 2; ++ai)
#pragma unroll
                for (int m = 0; m < 4; ++m) { const int row = row0 + ai * 128 + m * 16; const float r = rs[ai * 128 + wr * 64 + m * 16 + fr];
                    float* o = out + (size_t)row * DM + col; const u32x4 yv = *(const u32x4*)(Y1 + (size_t)row * DM + col);
                    const f32x4 ya = {bflo(yv.x), bfhi(yv.x), bflo(yv.y), bfhi(yv.y)}, yb = {bflo(yv.z), bfhi(yv.z), bflo(yv.w), bfhi(yv.w)};
                    __builtin_nontemporal_store(ya + ca * (acc[ai][bj][m][0] * r), (f32x4*)o); __builtin_nontemporal_store(yb + cb * (acc[ai][bj][m][1] * r), (f32x4*)(o + 4)); } }
    }
};

struct Args { const float* in[28]; float* out; unsigned char* ws; int ph_lo, ph_hi; };
constexpr int NPHASE = 12;

__global__ void __launch_bounds__(512, 2) mk_fwd(Args args) {
    extern __shared__ __attribute__((aligned(16))) unsigned char lds_raw[];
    LAS unsigned char* lds = (LAS unsigned char*)lds_raw;
    const int G = gridDim.x, bx = blockIdx.x;
    unsigned char* ws = args.ws; float* out = args.out; const float* const* in = args.in;
    const int lo = args.ph_lo, hi = args.ph_hi;
    if (lo < 0) cg::this_grid().sync();
    volatile LAS unsigned* bst = (volatile LAS unsigned*)(lds + LDS_BAR_OFF);
    if (threadIdx.x < 2) bst[threadIdx.x] = 0u;
    __syncthreads();
    XcdBarrier bar; bar.bar = (unsigned*)ws; bar.x = 0; bar.st = bst;
    if (hi - lo > 1) bar = xcd_barrier_post((unsigned*)ws, bst);
#ifndef P4SEL
#define P4SEL 7
#endif
#ifndef DUPMASK
#define DUPMASK 0
#endif
#define REP(k) for (int rep_ = 0; rep_ < 1 + ((DUPMASK >> (k)) & 1); ++rep_)
#ifndef PHMASK
#define PHMASK 0xfff
#endif
#define IN(k) (((PHMASK >> (k)) & 1) && lo <= (k) && (k) < hi)
#define SEAM(k) do { if (hi - lo > 1) { xcd_barrier(bar); } } while (0)
    typedef pg8::StaticOrder SO;
    if (IN(0)) REP(0) { phase0(lds, in, ws, G); __syncthreads(); }
    SEAM(0);
    if (IN(1)) REP(1) phase1(in, ws, G);
    SEAM(1);
    if (IN(2)) REP(2) {
        __syncthreads();
        pg8::Gemm g{(const bf16*)(ws + WS_H), (const bf16*)(ws + WS_WIN), NTOK, IN_WP, 1024}; SO S; S.init(NTOK, IN_WP, G, bx);
        Epi8<FInProj> E{{(bf16*)(ws + WS_PA), (bf16*)(ws + WS_Z), (bf16*)(ws + WS_XBC), (float*)(ws + WS_DTR)}};
        pg8::gemm_phase<Epi8<FInProj>, SO, true, true>(lds, g, S, E);
        if (G == 256) { if (bx >= 64) ffn_weight_copies(lds, in, ws, (bx - 64) * 8 + (int)(threadIdx.x >> 6), 192 * 8); }
        else ffn_weight_copies(lds, in, ws, bx * 8 + (int)(threadIdx.x >> 6), G * 8);
    }
    SEAM(2);
    if (IN(3)) REP(3) phase3(in, out, ws, G);
    SEAM(3);
    if (IN(4)) REP(4) {
        __syncthreads();
#if P4SEL & 1
        { pg8::Gemm g{(const bf16*)(ws + WS_QN), (const bf16*)(ws + WS_WUQ), NTOK, 768, 384}; SO S; S.init(NTOK, 768, G, bx);
          Epi8<FQUp> E{{(bf16*)(ws + WS_Q)}};
          pg8::gemm_phase<Epi8<FQUp>, SO, true, true>(lds, g, S, E); }
#endif
#if P4SEL & 2
        __syncthreads();
        { pg8::Gemm g{(const bf16*)(ws + WS_CKV), (const bf16*)(ws + WS_WKN), NKROW, 512, 256}; SO S; S.init(NKROW, 512, G, (bx + 64) % G);
          Epi8<FBf> E{{(bf16*)(ws + WS_KN), 512}};
          pg8::gemm_phase<Epi8<FBf>, SO, true, true>(lds, g, S, E); }
#endif
#if P4SEL & 4
        __syncthreads();
        { pg8::Gemm g{(const bf16*)(ws + WS_WV), (const bf16*)(ws + WS_CKV), 512, NKROW, 256}; SO S; S.init(512, NKROW, G, (bx + 176) % G);
          Epi8<FBf> E{{(bf16*)(ws + WS_VT), NKROW}};
          pg8::gemm_phase<Epi8<FBf>, SO, true, true>(lds, g, S, E); }
#endif
    }
    SEAM(4);
    if (IN(5)) phase5(lds, in, out, ws, G);
    SEAM(5);
    if (IN(6)) REP(6) phase6(in, ws, G);
    SEAM(6);
    if (IN(7)) {
        pg8::Gemm g{(const bf16*)(ws + WS_MIX), (const bf16*)(ws + WS_WOUT), NTOK, 1024, 1024}; SO S; S.init(NTOK, 1024, G, bx);
        EpiMixFused E{in[0], in[1], (bf16*)(ws + WS_Y1), (bf16*)(ws + WS_H), (const float*)(ws + WS_MOD), in[10], in[23], (float*)(ws + WS_PS1), (float*)(ws + WS_PS2), bar};
        pg8::gemm_phase<EpiMixFused, SO, false, true>(lds, g, S, E);
    }
    SEAM(7);
    if (IN(9)) REP(9) {
        __syncthreads();
        pg8::Gemm g{(const bf16*)(ws + WS_H), (const bf16*)(ws + WS_WGU), NTOK, 2 * DFF, 1024}; SO S; S.init(NTOK, 2 * DFF, G, bx);
        Epi8<FGateUp> E{{(bf16*)(ws + WS_ACT)}};
        pg8::gemm_phase<Epi8<FGateUp>, SO, true, true>(lds, g, S, E);
    }
    SEAM(9);
    if (IN(10)) {
        pg8::Gemm g{(const bf16*)(ws + WS_ACT), (const bf16*)(ws + WS_WDN), NTOK, 1024, DFF}; SO S; S.init(NTOK, 1024, G, bx);
        EpiFfnFused E{out, (const bf16*)(ws + WS_Y1), (const float*)(ws + WS_MOD), in[24], (float*)(ws + WS_PS3), bar};
        pg8::gemm_phase<EpiFfnFused, SO, false, true>(lds, g, S, E);
    }
#undef IN
#undef SEAM
}

extern "C" void kernel_launch(void* const* d_in, const int* in_sizes, int n_in, void* d_out, int out_size, void* d_ws, size_t ws_size, hipStream_t stream) {
    static int grid = 0;
    if (grid == 0) {
        int dev = 0, cus = 0, per_cu = 0;
        if (hipGetDevice(&dev) != hipSuccess || hipDeviceGetAttribute(&cus, hipDeviceAttributeMultiprocessorCount, dev) != hipSuccess) { fprintf(stderr, "kernel_launch: device query failed\n"); grid = -1; return; }
        if (hipFuncSetAttribute((const void*)mk_fwd, hipFuncAttributeMaxDynamicSharedMemorySize, LDS_BYTES) != hipSuccess) { fprintf(stderr, "kernel_launch: hipFuncSetAttribute failed\n"); grid = -1; return; }
        if (hipOccupancyMaxActiveBlocksPerMultiprocessor(&per_cu, (const void*)mk_fwd, 512, LDS_BYTES) != hipSuccess || per_cu < 1) { fprintf(stderr, "kernel_launch: occupancy query says %d blocks/CU\n", per_cu); grid = -1; return; }
        grid = cus;
        if (cus != 256) { fprintf(stderr, "kernel_launch: built for a 256-CU device (one 256x256 GEMM unit per workgroup in the fused-norm phases), got %d CUs\n", cus); grid = -1; return; }
        if (n_in != 28 || ws_size < 252 * MiB) { fprintf(stderr, "kernel_launch: unexpected n_in %d / ws %zu\n", n_in, ws_size); grid = -1; return; }
    }
    if (grid < 0) return;
    if (hipMemsetAsync(d_ws, 0, CTL_ZERO_BYTES, stream) != hipSuccess) { fprintf(stderr, "kernel_launch: memset failed\n"); return; }
    Args a{};
    for (int i = 0; i < 28; ++i) a.in[i] = (const float*)d_in[i];
    a.out = (float*)d_out; a.ws = (unsigned char*)d_ws;
    void* kargs[] = {&a};
#ifndef PROBE_HI
#define PROBE_HI 0
#endif
#if PROBE_HI > 0
    a.ph_lo = 0; a.ph_hi = PROBE_HI;
    (void)hipLaunchCooperativeKernel((const void*)mk_fwd, dim3(grid), dim3(512), kargs, LDS_BYTES, stream);
    (void)hipMemsetAsync(d_ws, 0, CTL_ZERO_BYTES, stream);
#endif
    a.ph_lo = 0; a.ph_hi = NPHASE;
    hipError_t e = hipLaunchCooperativeKernel((const void*)mk_fwd, dim3(grid), dim3(512), kargs, LDS_BYTES, stream);
    if (e != hipSuccess) fprintf(stderr, "kernel_launch: cooperative launch failed: %s (grid %d)\n", hipGetErrorString(e), grid);
}
```

```cpp
#include <hip/hip_runtime.h>
#include <hip/hip_cooperative_groups.h>
#include <cstdio>
#include <cstdint>
namespace cg = cooperative_groups;

#ifndef MK_SPLIT
#define MK_SPLIT 0
#endif

#define DI __device__ __forceinline__
#define LAS __attribute__((address_space(3)))
typedef unsigned short bf16;
typedef float f32x4 __attribute__((ext_vector_type(4)));
typedef float f32x16 __attribute__((ext_vector_type(16)));
typedef short bf16x8 __attribute__((ext_vector_type(8)));
typedef short s16x4 __attribute__((ext_vector_type(4)));
typedef unsigned u32x4 __attribute__((ext_vector_type(4)));
typedef unsigned u32x2 __attribute__((ext_vector_type(2)));
typedef float f32x2_t __attribute__((ext_vector_type(2)));

namespace pg8 {
#define PG8_LAS __attribute__((address_space(3)))
typedef unsigned short bf16_t;
typedef short bf16x8 __attribute__((ext_vector_type(8)));
typedef float f32x4 __attribute__((ext_vector_type(4)));
typedef unsigned u32x4 __attribute__((ext_vector_type(4)));
constexpr int BM = 256, BK = 64, HALF = 128, HTB = HALF * BK * 2, STAGE_BYTES = 8 * HTB, NXCD = 8, WGM = 8;

__host__ __device__ __forceinline__ int lds_byte(int r, int c) { const int st = (r >> 4) * 2 + (c >> 5), rr = r & 15, cc = c & 31, ob = rr * 64 + cc * 2; return st * 1024 + (ob ^ (((ob >> 9) & 1) << 5)); }
__host__ __device__ __forceinline__ void stage_rc(int b, int& R, int& C) { const int st = b / 1024, sb = b % 1024, swz = sb ^ (((sb >> 9) & 1) << 5); R = (st >> 1) * 16 + swz / 64; C = (st & 1) * 32 + (swz % 64) / 2; }
__host__ __device__ __forceinline__ int perm32(int rho) { const int n = rho >> 4, i = rho & 15; return 8 * (i >> 2) + 4 * n + (i & 3); }

struct Unit { int pm, pn; };
struct Gemm { const bf16_t* A; const bf16_t* Bt; int M, N, K; };

struct StaticOrder {
    int nM, nN, nwg, G, c;
    __host__ __device__ void init(int M, int N, int G_, int c_) { nM = M / BM; nN = N / BM; nwg = nM * nN; G = G_; c = c_; }
    __host__ __device__ bool next(int i, Unit& u) const {
        const long L = (long)i * G + c; if (L >= nwg) return false;
        int wgid = (int)L; { const int q = nwg / NXCD, r = nwg % NXCD, xcd = wgid % NXCD, off = wgid / NXCD; wgid = (xcd < r ? xcd * (q + 1) : r * (q + 1) + (xcd - r) * q) + off; }
        const int nig = WGM * nN, gid = wgid / nig, fm = gid * WGM, gsz = (nM - fm) < WGM ? (nM - fm) : WGM;
        u.pm = fm + ((wgid % nig) % gsz); u.pn = (wgid % nig) / gsz; return true;
    }
    __device__ __forceinline__ void a_ready(const Unit&) const {}
    __device__ __forceinline__ void done(const Unit&) const {}
};

template <class Epi, class Sched, bool ALIGN_EPI = false, bool SP2 = false>
__device__ __forceinline__ void gemm_phase(PG8_LAS unsigned char* lds, const Gemm g, const Sched& S, const Epi& E) {
    const int tid = threadIdx.x, wid = __builtin_amdgcn_readfirstlane(tid >> 6), lane = tid & 63, wr = wid >> 2, wc = wid & 3, fr = lane & 15, fq = lane >> 4;
    int Kop = g.K; asm volatile("" : "+s"(Kop));
    const int K = Kop, nt = K / BK;
    unsigned voffA[2], voffB[2];
#pragma unroll
    for (int i = 0; i < 2; ++i) { int R, C; stage_rc(tid * 16 + i * 8192, R, C); const int Rb = Epi::PERM ? ((R & ~31) + perm32(R & 31)) : R;
        voffA[i] = (unsigned)(R * K + C) * 2u; voffB[i] = (unsigned)(Rb * K + C) * 2u; }
    const size_t kstep = (size_t)(BK * 2);
    const size_t hstep = (size_t)HALF * K * 2;
    const size_t tstep = 2 * hstep;
    const unsigned ldsw = (unsigned)wid * 1024u;
    const int aoff = lds_byte(wr * 64 + fr, fq * 8), boff = lds_byte(wc * 32 + fr, fq * 8);
#define PG8_SA(b, h) (((b) * 2 + (h)) * HTB)
#define PG8_SB(b, h) ((4 + (b) * 2 + (h)) * HTB)
#define PG8_STAGE(bufoff, gbase, voff) do { _Pragma("unroll") for (int _i = 0; _i < 2; ++_i) \
        __builtin_amdgcn_global_load_lds((const unsigned*)((const char*)(gbase) + (voff)[_i]), (PG8_LAS unsigned*)(lds + (bufoff) + ldsw + _i * 8192), 16, 0, 0); } while (0)
#define PG8_LDA(dst, b, h) do { _Pragma("unroll") for (int m = 0; m < 4; ++m) _Pragma("unroll") for (int k = 0; k < 2; ++k) dst[m][k] = *(const PG8_LAS bf16x8*)(lds + PG8_SA(b, h) + aoff + m * 2048 + k * 1024); } while (0)
#define PG8_LDB(dst, b, h) do { _Pragma("unroll") for (int n = 0; n < 2; ++n) _Pragma("unroll") for (int k = 0; k < 2; ++k) dst[n][k] = *(const PG8_LAS bf16x8*)(lds + PG8_SB(b, h) + boff + n * 2048 + k * 1024); } while (0)
#define PG8_MMA(ai, bj, At, Bt) do { __builtin_amdgcn_s_setprio(1); _Pragma("unroll") for (int m = 0; m < 4; ++m) _Pragma("unroll") for (int n = 0; n < 2; ++n) _Pragma("unroll") for (int k = 0; k < 2; ++k) \
        acc[ai][bj][m][n] = __builtin_amdgcn_mfma_f32_16x16x32_bf16(Bt[n][k], At[m][k], acc[ai][bj][m][n], 0, 0, 0); __builtin_amdgcn_s_setprio(0); } while (0)
#define PG8_WAIT_V(n) asm volatile("s_waitcnt vmcnt(" #n ")" ::: "memory")
#define PG8_WAIT_L(n) asm volatile("s_waitcnt lgkmcnt(" #n ")" ::: "memory")
#define PG8_BAR __builtin_amdgcn_s_barrier()
#define PG8_SCHED __builtin_amdgcn_sched_barrier(0)
    Unit cur, nxt; int ui = 0;
    if (!S.next(0, cur)) return;
    f32x4 acc[2][2][4][2];
#pragma unroll
    for (int a = 0; a < 2; ++a)
#pragma unroll
        for (int b = 0; b < 2; ++b)
#pragma unroll
            for (int m = 0; m < 4; ++m)
#pragma unroll
                for (int n = 0; n < 2; ++n) acc[a][b][m][n] = (f32x4){0.f, 0.f, 0.f, 0.f};
    bf16x8 At[4][2], B0[2][2], B1[2][2];
    const char* cA = (const char*)g.A + (size_t)cur.pm * tstep; const char* cB = (const char*)g.Bt + (size_t)cur.pn * tstep;
    S.a_ready(cur);
    if constexpr (SP2) {
        PG8_STAGE(PG8_SB(0, 0), cB, voffB); PG8_STAGE(PG8_SB(0, 1), cB + hstep, voffB); PG8_STAGE(PG8_SA(0, 0), cA, voffA); PG8_STAGE(PG8_SA(0, 1), cA + hstep, voffA);
        if (wr == 1) PG8_BAR;
        PG8_WAIT_V(2); PG8_BAR;
        PG8_STAGE(PG8_SB(1, 0), cB + kstep, voffB); PG8_STAGE(PG8_SA(1, 0), cA + kstep, voffA); PG8_STAGE(PG8_SB(1, 1), cB + hstep + kstep, voffB);
        PG8_WAIT_V(6); PG8_BAR;
    } else {
        PG8_STAGE(PG8_SB(0, 0), cB, voffB); PG8_STAGE(PG8_SA(0, 0), cA, voffA); PG8_STAGE(PG8_SB(0, 1), cB + hstep, voffB); PG8_STAGE(PG8_SA(0, 1), cA + hstep, voffA);
        if (wr == 1) PG8_BAR;
        PG8_WAIT_V(4); PG8_BAR;
        PG8_STAGE(PG8_SB(1, 0), cB + kstep, voffB); PG8_STAGE(PG8_SA(1, 0), cA + kstep, voffA); PG8_STAGE(PG8_SB(1, 1), cB + hstep + kstep, voffB);
        PG8_WAIT_V(6); PG8_BAR;
    }
    for (;;) {
        const bool has_next = S.next(ui + 1, nxt);
        const char* nA = has_next ? (const char*)g.A + (size_t)nxt.pm * tstep : cA; const char* nB = has_next ? (const char*)g.Bt + (size_t)nxt.pn * tstep : cB;
#pragma unroll 1
        for (int t = 0; t < nt; t += 2) {
            const bool last = (t == nt - 2);
            const char* a1 = cA + (size_t)(t + 1) * kstep;
            const char* a2 = last ? nA : cA + (size_t)(t + 2) * kstep; const char* b2 = last ? nB : cB + (size_t)(t + 2) * kstep;
            const char* a3 = a2 + kstep; const char* b3 = b2 + kstep;
            if (last && has_next) S.a_ready(nxt);
            if constexpr (SP2) {
            PG8_LDB(B0, 0, 0); PG8_LDB(B1, 0, 1); PG8_SCHED; PG8_LDA(At, 0, 0); PG8_STAGE(PG8_SA(1, 1), a1 + hstep, voffA);
            PG8_WAIT_V(8); PG8_WAIT_L(0); PG8_BAR; PG8_MMA(0, 0, At, B0); PG8_MMA(0, 1, At, B1); PG8_BAR; PG8_SCHED;
            PG8_LDA(At, 0, 1); PG8_STAGE(PG8_SB(0, 0), b2, voffB); PG8_STAGE(PG8_SB(0, 1), b2 + hstep, voffB); PG8_STAGE(PG8_SA(0, 0), a2, voffA);
            PG8_WAIT_V(8); PG8_WAIT_L(0); PG8_BAR; PG8_MMA(1, 0, At, B0); PG8_MMA(1, 1, At, B1); PG8_BAR; PG8_SCHED;
            PG8_LDB(B0, 1, 0); PG8_LDB(B1, 1, 1); PG8_SCHED; PG8_LDA(At, 1, 0); PG8_STAGE(PG8_SA(0, 1), a2 + hstep, voffA);
            PG8_WAIT_V(8); PG8_WAIT_L(0); PG8_BAR; PG8_MMA(0, 0, At, B0); PG8_MMA(0, 1, At, B1); PG8_BAR; PG8_SCHED;
            PG8_LDA(At, 1, 1); PG8_STAGE(PG8_SB(1, 0), b3, voffB); PG8_STAGE(PG8_SB(1, 1), b3 + hstep, voffB); PG8_STAGE(PG8_SA(1, 0), a3, voffA);
            PG8_WAIT_V(8); PG8_WAIT_L(0); PG8_BAR; PG8_MMA(1, 0, At, B0); PG8_MMA(1, 1, At, B1); PG8_BAR; PG8_SCHED;
            } else {
            PG8_LDB(B0, 0, 0); PG8_SCHED; PG8_LDA(At, 0, 0); PG8_STAGE(PG8_SA(1, 1), a1 + hstep, voffA);
            PG8_WAIT_L(8); PG8_BAR; PG8_WAIT_L(0); PG8_MMA(0, 0, At, B0); PG8_BAR; PG8_SCHED;
            PG8_LDB(B1, 0, 1); PG8_STAGE(PG8_SB(0, 0), b2, voffB);
            PG8_BAR; PG8_WAIT_L(0); PG8_MMA(0, 1, At, B1); PG8_BAR;
            PG8_LDA(At, 0, 1); PG8_STAGE(PG8_SA(0, 0), a2, voffA);
            PG8_BAR; PG8_WAIT_L(0); PG8_MMA(1, 0, At, B0); PG8_BAR; PG8_SCHED;
            PG8_STAGE(PG8_SB(0, 1), b2 + hstep, voffB);
            PG8_WAIT_V(6); PG8_BAR; PG8_MMA(1, 1, At, B1); PG8_BAR;
            PG8_LDB(B0, 1, 0); PG8_SCHED; PG8_LDA(At, 1, 0); PG8_STAGE(PG8_SA(0, 1), a2 + hstep, voffA);
            PG8_WAIT_L(8); PG8_BAR; PG8_WAIT_L(0); PG8_MMA(0, 0, At, B0); PG8_BAR; PG8_SCHED;
            PG8_LDB(B1, 1, 1); PG8_STAGE(PG8_SB(1, 0), b3, voffB);
            PG8_BAR; PG8_WAIT_L(0); PG8_MMA(0, 1, At, B1); PG8_BAR;
            PG8_LDA(At, 1, 1); PG8_STAGE(PG8_SA(1, 0), a3, voffA);
            PG8_BAR; PG8_WAIT_L(0); PG8_MMA(1, 0, At, B0); PG8_BAR; PG8_SCHED;
            PG8_STAGE(PG8_SB(1, 1), b3 + hstep, voffB);
            PG8_WAIT_V(6); PG8_BAR; PG8_MMA(1, 1, At, B1); PG8_BAR;
            }
        }
        if constexpr (ALIGN_EPI) { if (wr == 0) PG8_BAR; }
        if constexpr (!Epi::AFTER_DRAIN) { E(acc, cur, wr, wc, fr, fq); S.done(cur); }
        if (!has_next) break;
#pragma unroll
        for (int a = 0; a < 2; ++a)
#pragma unroll
            for (int b = 0; b < 2; ++b)
#pragma unroll
                for (int m = 0; m < 4; ++m)
#pragma unroll
                    for (int n = 0; n < 2; ++n) acc[a][b][m][n] = (f32x4){0.f, 0.f, 0.f, 0.f};
        cur = nxt; cA = nA; cB = nB; ++ui;
        if constexpr (ALIGN_EPI) { if (wr == 1) PG8_BAR; }
    }
    PG8_WAIT_V(0);
    if constexpr (!ALIGN_EPI) { if (wr == 0) PG8_BAR; }
    PG8_BAR;
    if constexpr (Epi::AFTER_DRAIN) { E.fused(acc, cur, wr, wc, fr, fq, lds, wid, lane); }
#undef PG8_SA
#undef PG8_SB
#undef PG8_STAGE
#undef PG8_LDA
#undef PG8_LDB
#undef PG8_MMA
#undef PG8_WAIT_V
#undef PG8_WAIT_L
#undef PG8_BAR
#undef PG8_SCHED
}
}

constexpr int DM = 1024, NCTX = 8192, NTOK = 16384, NKROW = 18432;
constexpr int IN_W = 2256, IN_WP = 2304, DFF = 2816;
constexpr float NORM_EPS = 1e-6f;
constexpr float QSCALE = 0.07216878364870322f * 1.4426950408889634f;

constexpr size_t MiB = 1u << 20;
constexpr size_t WS_MOD = 1 * MiB, WS_ROPE = 1 * MiB + 512 * 1024;
constexpr size_t WS_WIN = 2 * MiB, WS_WUQ = 6 * MiB + 512 * 1024, WS_WKN = 7 * MiB + 256 * 1024, WS_WV = 7 * MiB + 512 * 1024, WS_WOUT = 8 * MiB, WS_WGU = 10 * MiB, WS_WDN = 21 * MiB;
constexpr size_t WS_DTR = 27 * MiB, WS_DT = 28 * MiB;
constexpr size_t WS_H = 30 * MiB, WS_PA = 62 * MiB, WS_Z = 84 * MiB, WS_XBC = 100 * MiB, WS_QN = 132 * MiB, WS_CKV = 144 * MiB, WS_KR = 153 * MiB, WS_XS = 156 * MiB;
constexpr size_t WS_YF = 188 * MiB, WS_YB = 220 * MiB;
constexpr size_t WS_Q = 30 * MiB, WS_KN = 54 * MiB, WS_VT = 100 * MiB, WS_MIX = 118 * MiB, WS_OM = 150 * MiB, WS_ACT = 62 * MiB, WS_F = 150 * MiB;
constexpr size_t WS_Y1 = 150 * MiB;
constexpr int LDS_BYTES = 147456;

DI unsigned pk2(float lo, float hi) { unsigned r; asm volatile("v_cvt_pk_bf16_f32 %0, %1, %2" : "=v"(r) : "v"(lo), "v"(hi)); return r; }
DI float bflo(unsigned u) { return __uint_as_float(u << 16); }
DI float bfhi(unsigned u) { return __uint_as_float(u & 0xffff0000u); }
DI float bf2f(unsigned short b) { return __uint_as_float((unsigned)b << 16); }
DI unsigned short f2bf1(float f) { return (unsigned short)(pk2(f, 0.f) & 0xffffu); }
DI float wave_sum(float v) {
#pragma unroll
    for (int o = 1; o < 64; o <<= 1) v += __shfl_xor(v, o);
    return v;
}
DI float silu_f(float v) { return v * __builtin_amdgcn_rcpf(1.f + __expf(-v)); }
DI int crow(int i, int h) { return (i & 3) + 8 * (i >> 2) + 4 * h; }
#define LDS_WAIT() asm volatile("s_waitcnt lgkmcnt(0)" ::: "memory")
#define MFMA32(a, b, c) __builtin_amdgcn_mfma_f32_32x32x16_bf16((a), (b), (c), 0, 0, 0)
#define MFMA16(a, b, c) __builtin_amdgcn_mfma_f32_16x16x32_bf16((a), (b), (c), 0, 0, 0)

template <class F> struct Epi8 {
    static constexpr bool PERM = true, AFTER_DRAIN = false;
    F f;
    DI void operator()(const f32x4 (&acc)[2][2][4][2], const pg8::Unit& u, int wr, int wc, int fr, int fq) const {
        const int row0 = u.pm * 256 + wr * 64 + fr, col0 = u.pn * 256 + wc * 32 + 8 * fq;
#pragma unroll
        for (int ai = 0; ai < 2; ++ai)
#pragma unroll
            for (int m = 0; m < 4; ++m)
#pragma unroll
                for (int bj = 0; bj < 2; ++bj) f(row0 + ai * 128 + m * 16, col0 + bj * 128, acc[ai][bj][m][0], acc[ai][bj][m][1]);
    }
};
DI void st8bf(bf16* p, f32x4 v0, f32x4 v1) { u32x4 w; w.x = pk2(v0[0], v0[1]); w.y = pk2(v0[2], v0[3]); w.z = pk2(v1[0], v1[1]); w.w = pk2(v1[2], v1[3]); *(u32x4*)p = w; }
DI void st8f(float* p, f32x4 v0, f32x4 v1) { *(f32x4*)p = v0; *(f32x4*)(p + 4) = v1; }

struct FInProj { bf16* PA; bf16* Z; bf16* XBC; float* DTR;
    DI void operator()(int row, int col, f32x4 v0, f32x4 v1) const {
        if (col < 704) st8bf(PA + (size_t)row * 704 + col, v0, v1);
        else if (col < 1216) st8bf(Z + (size_t)row * 512 + (col - 704), v0, v1);
        else if (col < 2240) st8bf(XBC + (size_t)row * 1024 + (col - 1216), v0, v1);
        else if (col < 2256) st8f(DTR + (size_t)row * 16 + (col - 2240), v0, v1);
    }
};
struct FQUp { bf16* Q;
    DI void operator()(int row, int col, f32x4 v0, f32x4 v1) const { st8bf(Q + (size_t)row * 768 + col, v0 * QSCALE, v1 * QSCALE); }
};
struct FBf { bf16* O; int ld; DI void operator()(int row, int col, f32x4 v0, f32x4 v1) const { st8bf(O + (size_t)row * ld + col, v0, v1); } };
struct FF32 { float* O; int ld; DI void operator()(int row, int col, f32x4 v0, f32x4 v1) const { st8f(O + (size_t)row * ld + col, v0, v1); } };
struct EpiGateUp {
    static constexpr bool PERM = true, AFTER_DRAIN = false;
    bf16* ACT;
    DI void operator()(const f32x4 (&acc)[2][2][4][2], const pg8::Unit& u, int wr, int wc, int fr, int fq) const {
        const int row0 = u.pm * 256 + wr * 64 + fr, f0 = u.pn * 128 + wc * 32 + 8 * fq;
#pragma unroll
        for (int ai = 0; ai < 2; ++ai)
#pragma unroll
            for (int m = 0; m < 4; ++m) { const f32x4 g0 = acc[ai][0][m][0], g1 = acc[ai][0][m][1], u0 = acc[ai][1][m][0], u1 = acc[ai][1][m][1];
                u32x4 w; w.x = pk2(silu_f(g0[0]) * u0[0], silu_f(g0[1]) * u0[1]); w.y = pk2(silu_f(g0[2]) * u0[2], silu_f(g0[3]) * u0[3]);
                w.z = pk2(silu_f(g1[0]) * u1[0], silu_f(g1[1]) * u1[1]); w.w = pk2(silu_f(g1[2]) * u1[2], silu_f(g1[3]) * u1[3]);
                *(u32x4*)(ACT + (size_t)(row0 + ai * 128 + m * 16) * DFF + f0) = w; }
    }
};

template <int MODE  >
DI void tr_item(const float* W, int K, int N, bf16* WT, LAS float* scr, int kb, int nb, int lane, int dst_row0) {
    const int k0 = 64 * kb, n0 = 32 * nb, nn = n0 + (lane & 31);
#pragma unroll
    for (int i = 0; i < 32; ++i) { const int kk = 2 * i + (lane >> 5); scr[kk * 33 + (lane & 31)] = (nn < N) ? __builtin_nontemporal_load(W + (size_t)(k0 + kk) * N + nn) : 0.f; }
    LDS_WAIT(); asm volatile("" ::: "memory");
    const int c = lane & 7;
#pragma unroll
    for (int j = 0; j < 4; ++j) { const int nl = (lane >> 3) + 8 * j; const LAS float* s = scr + (8 * c) * 33 + nl;
        u32x4 o; o.x = pk2(s[0 * 33], s[1 * 33]); o.y = pk2(s[2 * 33], s[3 * 33]); o.z = pk2(s[4 * 33], s[5 * 33]); o.w = pk2(s[6 * 33], s[7 * 33]);
        const int f = n0 + nl;
        const int row = (MODE == 0) ? (dst_row0 + nl) : ((f >> 7) * 256 + (MODE == 2 ? 128 : 0) + (f & 127));
        *(u32x4*)(WT + (size_t)row * K + k0 + 8 * c) = o; }
    LDS_WAIT(); asm volatile("" ::: "memory");
}

DI void phase0(LAS unsigned char* lds, const float* const* in, unsigned char* ws, int G) {
    const int tid = threadIdx.x, lane = tid & 63, wave = tid >> 6, bx = blockIdx.x;
    const float* c = in[5]; const float* c_ctx = in[6]; const float* w_mod = in[7]; const float* b_mod = in[8];
    float* mod = (float*)(ws + WS_MOD);
    if (bx < 192) {
        LAS float* sc = (LAS float*)lds;
        LAS float* red = (LAS float*)(lds + 36864);
        for (int i = tid; i < 9 * 1024; i += 512) { const int j = i >> 10, k = i & 1023; const float v = (j == 0) ? c_ctx[k] : c[(j - 1) * 1024 + k]; sc[i] = v / (1.f + expf(-v)); }
        __syncthreads();
        for (int item = bx; item < 192; item += G) {
            const int cc = tid & 31, kg = tid >> 5, col = item * 32 + cc;
            float a0 = 0.f, a1 = 0.f, a2 = 0.f, a3 = 0.f, a4 = 0.f, a5 = 0.f, a6 = 0.f, a7 = 0.f, a8 = 0.f;
#pragma unroll 16
            for (int i = 0; i < 64; ++i) { const int k = kg * 64 + i; const float w = __builtin_nontemporal_load(w_mod + (size_t)k * 6144 + col);
                a0 += sc[k] * w; a1 += sc[1024 + k] * w; a2 += sc[2048 + k] * w; a3 += sc[3072 + k] * w; a4 += sc[4096 + k] * w;
                a5 += sc[5120 + k] * w; a6 += sc[6144 + k] * w; a7 += sc[7168 + k] * w; a8 += sc[8192 + k] * w; }
            LAS float* rp = red + kg * 288 + cc;
            rp[0] = a0; rp[32] = a1; rp[64] = a2; rp[96] = a3; rp[128] = a4; rp[160] = a5; rp[192] = a6; rp[224] = a7; rp[256] = a8;
            __syncthreads();
            if (tid < 288) { const int j = tid >> 5, c2 = tid & 31; float s = b_mod[item * 32 + c2];
#pragma unroll
                for (int q = 0; q < 16; ++q) s += red[q * 288 + j * 32 + c2];
                mod[j * 6144 + item * 32 + c2] = s; }
            __syncthreads();
        }
    }
    if (bx == G - 1) {
        float* T = (float*)(ws + WS_ROPE);
        for (int e = tid; e < 1024; e += 512) { const int pos = e >> 4, i = e & 15;
            const float invf = exp2f(-(float)i * (13.287712379549449f / 16.f));
            const float ang = (float)pos * invf;
            const float n = rintf(ang * 0.15915494309189535f);
            float r = fmaf(-n, 6.28125f, ang); r = fmaf(-n, 1.9353071795864769e-3f, r);
            T[2 * e] = cosf(r); T[2 * e + 1] = sinf(r); }
    }
    __syncthreads();
    LAS float* scr = (LAS float*)(lds + 57344 + wave * 8704);
    const int gw = bx * 8 + wave, NGW = G * 8;
    constexpr int I_IN = 16 * 72, I_UQ = 6 * 24, I_KV = 4 * 32, I_OUT = 16 * 32;
    constexpr int NITEMS = I_IN + I_UQ + I_KV + I_OUT;
    for (int it = gw; it < NITEMS; it += NGW) {
        int r = it;
        if (r < I_IN) { const int kb = r / 72, nb = r % 72; tr_item<0>(in[11], 1024, IN_W, (bf16*)(ws + WS_WIN), scr, kb, nb, lane, 32 * nb); continue; } r -= I_IN;
        if (r < I_UQ) { const int kb = r / 24, nb = r % 24; tr_item<0>(in[13], 384, 768, (bf16*)(ws + WS_WUQ), scr, kb, nb, lane, 32 * nb); continue; } r -= I_UQ;
        if (r < I_KV) { const int kb = r / 32, nb = r % 32, c0 = 32 * nb, hh = c0 >> 8, e0 = c0 & 255;
            if (e0 < 128) tr_item<0>(in[15], 256, 1024, (bf16*)(ws + WS_WKN), scr, kb, nb, lane, hh * 128 + e0);
            else tr_item<0>(in[15], 256, 1024, (bf16*)(ws + WS_WV), scr, kb, nb, lane, hh * 128 + e0 - 128);
            continue; } r -= I_KV;
        { const int kb = r / 32, nb = r % 32; tr_item<0>(in[22], 1024, 1024, (bf16*)(ws + WS_WOUT), scr, kb, nb, lane, 32 * nb); }
    }
}
DI void ffn_weight_copies(LAS unsigned char* lds, const float* const* in, unsigned char* ws, int gw, int NGW) {
    const int lane = threadIdx.x & 63, wave = threadIdx.x >> 6;
    LAS float* scr = (LAS float*)(lds + 57344 + wave * 8704);
    constexpr int I_G = 16 * 88, I_DN = 44 * 32;
    for (int it = gw; it < 2 * I_G + I_DN; it += NGW) {
        int r = it;
        if (r < I_G) { const int kb = r / 88, nb = r % 88; tr_item<1>(in[25], 1024, DFF, (bf16*)(ws + WS_WGU), scr, kb, nb, lane, 0); continue; } r -= I_G;
        if (r < I_G) { const int kb = r / 88, nb = r % 88; tr_item<2>(in[26], 1024, DFF, (bf16*)(ws + WS_WGU), scr, kb, nb, lane, 0); continue; } r -= I_G;
        { const int kb = r / 32, nb = r % 32; tr_item<0>(in[27], DFF, 1024, (bf16*)(ws + WS_WDN), scr, kb, nb, lane, 32 * nb); }
    }
}

DI const float* xrow_ptr(const float* const* in, int r) { return (r < NCTX) ? in[0] + (size_t)r * DM : in[1] + (size_t)(r - NCTX) * DM; }
DI int mod_idx(int r) { return (r < NCTX) ? 0 : 1 + ((r - NCTX) >> 10); }

DI void phase1(const float* const* in, unsigned char* ws, int G) {
    const int lane = threadIdx.x & 63, wave = threadIdx.x >> 6, gw = blockIdx.x * 8 + wave, NGW = G * 8;
    const float* mod = (const float*)(ws + WS_MOD); const float* gp = in[9]; bf16* H = (bf16*)(ws + WS_H);
    f32x4 g[4];
#pragma unroll
    for (int j = 0; j < 4; ++j) g[j] = *(const f32x4*)(gp + 4 * lane + 256 * j);
    for (int r0 = gw; r0 < NTOK; r0 += 4 * NGW) {
        f32x4 v[4][4]; float s[4];
#pragma unroll
        for (int q = 0; q < 4; ++q) { const int r = r0 + q * NGW; const f32x4* xr = (const f32x4*)xrow_ptr(in, r < NTOK ? r : r0) + lane;
#pragma unroll
            for (int j = 0; j < 4; ++j) v[q][j] = __builtin_nontemporal_load(xr + 64 * j); }
#pragma unroll
        for (int q = 0; q < 4; ++q) { s[q] = 0.f;
#pragma unroll
            for (int j = 0; j < 4; ++j) s[q] += v[q][j].x * v[q][j].x + v[q][j].y * v[q][j].y + v[q][j].z * v[q][j].z + v[q][j].w * v[q][j].w; }
#pragma unroll
        for (int o = 1; o < 64; o <<= 1) {
#pragma unroll
            for (int q = 0; q < 4; ++q) s[q] += __shfl_xor(s[q], o); }
#pragma unroll
        for (int q = 0; q < 4; ++q) { const int r = r0 + q * NGW; if (r >= NTOK) break;
            const float rstd = rsqrtf(s[q] * (1.f / DM) + NORM_EPS); const float* mj = mod + mod_idx(r) * 6144;
            u32x2* o = (u32x2*)(H + (size_t)r * DM) + lane;
#pragma unroll
            for (int j = 0; j < 4; ++j) { const int k = 4 * lane + 256 * j;
                const f32x4 sc = *(const f32x4*)(mj + 1024 + k), sh = *(const f32x4*)(mj + k);
                const f32x4 h = v[q][j] * rstd * g[j] * (sc + 1.f) + sh;
                u32x2 w; w.x = pk2(h.x, h.y); w.y = pk2(h.z, h.w); o[64 * j] = w; } }
    }
}

struct P3Row { unsigned q0, q1, q2, k0, k1; unsigned short kr; u32x4 m1[2], c0[2], p1[2]; float dtr; };
DI void p3_load(P3Row& R, const bf16* PA, const bf16* XBC, const float* DTR, int r, int lane) {
    const bool ctx = r < NCTX; const int l = ctx ? (r & 255) : ((r - NCTX) & 1023), L = ctx ? 256 : 1024;
    const unsigned* pa = (const unsigned*)(PA + (size_t)r * 704);
    R.q0 = pa[lane]; R.q1 = pa[lane + 64]; R.q2 = pa[lane + 128]; R.k0 = pa[192 + lane]; R.k1 = pa[256 + lane];
    R.kr = PA[(size_t)r * 704 + 640 + lane];
    const u32x4 z4 = {0u, 0u, 0u, 0u};
#pragma unroll
    for (int jj = 0; jj < 2; ++jj) { const int ch = 8 * lane + 512 * jj;
        R.m1[jj] = (l > 0) ? *(const u32x4*)(XBC + (size_t)(r - 1) * 1024 + ch) : z4;
        R.c0[jj] = *(const u32x4*)(XBC + (size_t)r * 1024 + ch);
        R.p1[jj] = (l < L - 1) ? *(const u32x4*)(XBC + (size_t)(r + 1) * 1024 + ch) : z4; }
    R.dtr = DTR[(size_t)r * 16 + (lane & 15)];
}
DI void phase3(const float* const* in, float* out, unsigned char* ws, int G) {
    const int lane = threadIdx.x & 63, wave = threadIdx.x >> 6, gw = blockIdx.x * 8 + wave, NGW = G * 8;
    const bf16* PA = (const bf16*)(ws + WS_PA); const bf16* XBC = (const bf16*)(ws + WS_XBC);
    const float* DTR = (const float*)(ws + WS_DTR); float* DT = (float*)(ws + WS_DT);
    bf16* QN = (bf16*)(ws + WS_QN); bf16* CKV = (bf16*)(ws + WS_CKV); bf16* KR = (bf16*)(ws + WS_KR); bf16* XS = (bf16*)(ws + WS_XS);
    const float* rope = (const float*)(ws + WS_ROPE);
    const float* g_q = in[12]; const float* g_kv = in[14]; const float* conv_w = in[16]; const float* conv_b = in[17]; const float* dt_bias = in[18];
    float* out_ckv = out + 2 * (size_t)NCTX * DM; float* out_kr = out_ckv + (size_t)NCTX * 256;
    for (int rr = gw; rr < 2048; rr += NGW) {
        const int b = rr >> 8, j = rr & 255; const size_t krow = (size_t)NCTX + b * 1280 + j;
        const f32x4 v = __builtin_nontemporal_load((const f32x4*)(in[2] + (size_t)rr * 256) + lane);
        u32x2 w; w.x = pk2(v.x, v.y); w.y = pk2(v.z, v.w); *((u32x2*)(CKV + krow * 256) + lane) = w;
        KR[krow * 64 + lane] = f2bf1(in[3][(size_t)rr * 64 + lane]);
    }
    const float gq0 = g_q[2 * lane], gq1 = g_q[2 * lane + 1], gq2 = g_q[2 * lane + 128], gq3 = g_q[2 * lane + 129], gq4 = g_q[2 * lane + 256], gq5 = g_q[2 * lane + 257];
    const float gk0 = g_kv[2 * lane], gk1 = g_kv[2 * lane + 1], gk2 = g_kv[2 * lane + 128], gk3 = g_kv[2 * lane + 129];
    const float dtb = dt_bias[lane & 15];
    P3Row cur, nxt;
    if (gw < NTOK) p3_load(cur, PA, XBC, DTR, gw, lane);
    for (int r = gw; r < NTOK; r += NGW) {
        if (r + NGW < NTOK) p3_load(nxt, PA, XBC, DTR, r + NGW, lane);
        const bool ctx = r < NCTX;
        const int bl = ctx ? (r >> 8) : ((r - NCTX) >> 10), l = ctx ? (r & 255) : ((r - NCTX) & 1023);
        const size_t krow = ctx ? (size_t)r : (size_t)NCTX + bl * 1280 + 256 + l;
        { float a0 = bflo(cur.q0), a1 = bfhi(cur.q0), b0 = bflo(cur.q1), b1 = bfhi(cur.q1), c0 = bflo(cur.q2), c1 = bfhi(cur.q2);
          const float rstd = rsqrtf(wave_sum(a0 * a0 + a1 * a1 + b0 * b0 + b1 * b1 + c0 * c0 + c1 * c1) * (1.f / 384.f) + NORM_EPS);
          unsigned* q = (unsigned*)(QN + (size_t)r * 384);
          q[lane] = pk2(a0 * rstd * gq0, a1 * rstd * gq1); q[lane + 64] = pk2(b0 * rstd * gq2, b1 * rstd * gq3); q[lane + 128] = pk2(c0 * rstd * gq4, c1 * rstd * gq5); }
        { float a0 = bflo(cur.k0), a1 = bfhi(cur.k0), b0 = bflo(cur.k1), b1 = bfhi(cur.k1);
          const float rstd = rsqrtf(wave_sum(a0 * a0 + a1 * a1 + b0 * b0 + b1 * b1) * (1.f / 256.f) + NORM_EPS);
          a0 *= rstd * gk0; a1 *= rstd * gk1; b0 *= rstd * gk2; b1 *= rstd * gk3;
          unsigned* k = (unsigned*)(CKV + krow * 256); k[lane] = pk2(a0, a1); k[lane + 64] = pk2(b0, b1);
          if (ctx) { float* o = out_ckv + (size_t)r * 256; __builtin_nontemporal_store((f32x2_t){a0, a1}, (f32x2_t*)(o + 2 * lane)); __builtin_nontemporal_store((f32x2_t){b0, b1}, (f32x2_t*)(o + 2 * lane + 128)); } }
        { float v = bf2f(cur.kr);
          if (ctx) out_kr[(size_t)r * 64 + lane] = v;
          const float p = __shfl_xor(v, 16);
          if (!ctx) { const int pos = (lane < 32) ? (l >> 6) : (l & 63), idx = lane & 15; const float cs = rope[(pos * 16 + idx) * 2], sn = rope[(pos * 16 + idx) * 2 + 1];
              v = (lane & 16) ? (v * cs + p * sn) : (v * cs - p * sn); }
          KR[krow * 64 + lane] = f2bf1(v); }
#pragma unroll
        for (int jj = 0; jj < 2; ++jj) { const int ch = 8 * lane + 512 * jj;
            const f32x4 w0a = *(const f32x4*)(conv_w + ch), w0b = *(const f32x4*)(conv_w + ch + 4);
            const f32x4 w1a = *(const f32x4*)(conv_w + 1024 + ch), w1b = *(const f32x4*)(conv_w + 1024 + ch + 4);
            const f32x4 w2a = *(const f32x4*)(conv_w + 2048 + ch), w2b = *(const f32x4*)(conv_w + 2048 + ch + 4);
            const f32x4 ba = *(const f32x4*)(conv_b + ch), bb = *(const f32x4*)(conv_b + ch + 4);
            float y[8];
#pragma unroll
            for (int e = 0; e < 4; ++e) {
                const unsigned um = cur.m1[jj][e], uc = cur.c0[jj][e], up = cur.p1[jj][e];
                const float wlo0 = (e < 2) ? w0a[2 * e] : w0b[2 * e - 4], whi0 = (e < 2) ? w0a[2 * e + 1] : w0b[2 * e - 3];
                const float wlo1 = (e < 2) ? w1a[2 * e] : w1b[2 * e - 4], whi1 = (e < 2) ? w1a[2 * e + 1] : w1b[2 * e - 3];
                const float wlo2 = (e < 2) ? w2a[2 * e] : w2b[2 * e - 4], whi2 = (e < 2) ? w2a[2 * e + 1] : w2b[2 * e - 3];
                const float blo = (e < 2) ? ba[2 * e] : bb[2 * e - 4], bhi = (e < 2) ? ba[2 * e + 1] : bb[2 * e - 3];
                y[2 * e] = silu_f(blo + bflo(um) * wlo0 + bflo(uc) * wlo1 + bflo(up) * wlo2);
                y[2 * e + 1] = silu_f(bhi + bfhi(um) * whi0 + bfhi(uc) * whi1 + bfhi(up) * whi2);
            }
            u32x4 o; o.x = pk2(y[0], y[1]); o.y = pk2(y[2], y[3]); o.z = pk2(y[4], y[5]); o.w = pk2(y[6], y[7]);
            *(u32x4*)(XS + (size_t)r * 1024 + ch) = o; }
        if (lane < 16) { const float x = cur.dtr + dtb; DT[(size_t)r * 16 + lane] = fmaxf(x, 0.f) + log1pf(__expf(-fabsf(x))); }
        cur = nxt;
    }
}

struct P6Row { u32x4 yf, yb, xs, zz; };
DI void p6_load(P6Row& R, const bf16* YF, const bf16* YB, const bf16* XS, const bf16* Z, int r, int ch) {
    R.yf = *(const u32x4*)(YF + (size_t)r * 512 + ch); R.yb = *(const u32x4*)(YB + (size_t)r * 512 + ch);
    R.xs = *(const u32x4*)(XS + (size_t)r * 1024 + ch); R.zz = *(const u32x4*)(Z + (size_t)r * 512 + ch);
}
DI void phase6(const float* const* in, unsigned char* ws, int G) {
    const int lane = threadIdx.x & 63, wave = threadIdx.x >> 6, gw = blockIdx.x * 8 + wave, NGW = G * 8;
    const bf16* YF = (const bf16*)(ws + WS_YF); const bf16* YB = (const bf16*)(ws + WS_YB); const bf16* XS = (const bf16*)(ws + WS_XS); const bf16* Z = (const bf16*)(ws + WS_Z);
    bf16* MIX = (bf16*)(ws + WS_MIX); const float* d_skip = in[20]; const float* g_out = in[21];
    const int ch = 8 * lane; const float dsk = d_skip[lane >> 3];
    const f32x4 g0 = *(const f32x4*)(g_out + ch), g1 = *(const f32x4*)(g_out + ch + 4);
    P6Row cur, nxt;
    if (gw < NTOK) p6_load(cur, YF, YB, XS, Z, gw, ch);
    for (int r = gw; r < NTOK; r += NGW) {
        if (r + NGW < NTOK) p6_load(nxt, YF, YB, XS, Z, r + NGW, ch);
        float y[8]; float s = 0.f;
#pragma unroll
        for (int e = 0; e < 4; ++e) {
            const float ylo = bflo(cur.yf[e]) + bflo(cur.yb[e]) + dsk * bflo(cur.xs[e]);
            const float yhi = bfhi(cur.yf[e]) + bfhi(cur.yb[e]) + dsk * bfhi(cur.xs[e]);
            y[2 * e] = ylo * silu_f(bflo(cur.zz[e])); y[2 * e + 1] = yhi * silu_f(bfhi(cur.zz[e]));
            s += y[2 * e] * y[2 * e] + y[2 * e + 1] * y[2 * e + 1];
        }
        const float rstd = rsqrtf(wave_sum(s) * (1.f / 512.f) + NORM_EPS);
        u32x4 o; o.x = pk2(y[0] * rstd * g0[0], y[1] * rstd * g0[1]); o.y = pk2(y[2] * rstd * g0[2], y[3] * rstd * g0[3]);
        o.z = pk2(y[4] * rstd * g1[0], y[5] * rstd * g1[1]); o.w = pk2(y[6] * rstd * g1[2], y[7] * rstd * g1[3]);
        *(u32x4*)(MIX + (size_t)r * 1024 + 512 + ch) = o;
        cur = nxt;
    }
}

DI void phase8(const float* const* in, float* out, unsigned char* ws, int G) {
    const int lane = threadIdx.x & 63, wave = threadIdx.x >> 6, gw = blockIdx.x * 8 + wave, NGW = G * 8;
    const float* mod = (const float*)(ws + WS_MOD); const float* OM = (const float*)(ws + WS_OM); bf16* H = (bf16*)(ws + WS_H);
    const float* g_post = in[10]; const float* g_pre = in[23];
    for (int r = gw; r < NTOK; r += NGW) {
        const f32x4* xr = (const f32x4*)xrow_ptr(in, r) + lane; const f32x4* om = (const f32x4*)(OM + (size_t)r * DM) + lane; const float* mj = mod + mod_idx(r) * 6144;
        f32x4 v[4], y[4]; float s = 0.f;
#pragma unroll
        for (int j = 0; j < 4; ++j) { v[j] = om[64 * j]; s += v[j].x * v[j].x + v[j].y * v[j].y + v[j].z * v[j].z + v[j].w * v[j].w; }
        const float rstd = rsqrtf(wave_sum(s) * (1.f / DM) + NORM_EPS);
        float s2 = 0.f;
#pragma unroll
        for (int j = 0; j < 4; ++j) { const int k = 4 * lane + 256 * j;
            const f32x4 g = *(const f32x4*)(g_post + k), gt = *(const f32x4*)(mj + 2048 + k);
            y[j] = xr[64 * j] + gt * (v[j] * rstd * g);
            s2 += y[j].x * y[j].x + y[j].y * y[j].y + y[j].z * y[j].z + y[j].w * y[j].w;
            *((f32x4*)(out + (size_t)r * DM) + lane + 64 * j) = y[j]; }
        const float rstd2 = rsqrtf(wave_sum(s2) * (1.f / DM) + NORM_EPS);
        u32x2* o = (u32x2*)(H + (size_t)r * DM) + lane;
#pragma unroll
        for (int j = 0; j < 4; ++j) { const int k = 4 * lane + 256 * j;
            const f32x4 g = *(const f32x4*)(g_pre + k), sc = *(const f32x4*)(mj + 4096 + k), sh = *(const f32x4*)(mj + 3072 + k);
            const f32x4 h = y[j] * rstd2 * g * (sc + 1.f) + sh;
            u32x2 w; w.x = pk2(h.x, h.y); w.y = pk2(h.z, h.w); o[64 * j] = w; }
    }
}

DI void phase11(const float* const* in, float* out, unsigned char* ws, int G) {
    const int lane = threadIdx.x & 63, wave = threadIdx.x >> 6, gw = blockIdx.x * 8 + wave, NGW = G * 8;
    const float* mod = (const float*)(ws + WS_MOD); const float* F = (const float*)(ws + WS_F); const float* g_post = in[24];
    for (int r = gw; r < NTOK; r += NGW) {
        const f32x4* fr = (const f32x4*)(F + (size_t)r * DM) + lane; const float* mj = mod + mod_idx(r) * 6144;
        f32x4 v[4]; float s = 0.f;
#pragma unroll
        for (int j = 0; j < 4; ++j) { v[j] = fr[64 * j]; s += v[j].x * v[j].x + v[j].y * v[j].y + v[j].z * v[j].z + v[j].w * v[j].w; }
        const float rstd = rsqrtf(wave_sum(s) * (1.f / DM) + NORM_EPS);
#pragma unroll
        for (int j = 0; j < 4; ++j) { const int k = 4 * lane + 256 * j;
            const f32x4 g = *(const f32x4*)(g_post + k), gt = *(const f32x4*)(mj + 5120 + k);
            f32x4* o = (f32x4*)(out + (size_t)r * DM) + lane + 64 * j;
            *o = *o + gt * (v[j] * rstd * g); }
    }
}

constexpr int AK_STRIDE = 400, AV_STRIDE = 144, AV_OFF = 64 * AK_STRIDE, A_STAGE = AV_OFF + 128 * AV_STRIDE;
DI void attn_unit(LAS unsigned char* lds, const bf16* Q, const bf16* KN, const bf16* KR, const bf16* VT, bf16* MIX, const float* rope, int qrow0, int krow0, int nkt, int hh) {
    const int tid = threadIdx.x, lane = tid & 63, wave = tid >> 6, rg = wave & 3, kh = wave >> 2, r = lane & 31, hf = lane >> 5;
    bf16x8 qf[12];
    { const bf16* qp = Q + (size_t)(qrow0 + 32 * rg + r) * 768 + hh * 192 + 8 * hf;
#pragma unroll
      for (int ks = 0; ks < 12; ++ks) qf[ks] = *(const bf16x8*)(qp + 16 * ks); }
    if (rope) {
        const int l = (qrow0 + 32 * rg + r - NCTX) & 1023;
#pragma unroll
        for (int hfi = 0; hfi < 2; ++hfi) {
            const int pos = hfi ? (l & 63) : (l >> 6);
            const float* t = rope + (pos * 16 + 8 * hf) * 2;
            const u32x4 a = __builtin_bit_cast(u32x4, qf[8 + 2 * hfi]), b = __builtin_bit_cast(u32x4, qf[9 + 2 * hfi]); u32x4 ao, bo;
#pragma unroll
            for (int e = 0; e < 4; ++e) {
                const float x1l = bflo(a[e]), x1h = bfhi(a[e]), x2l = bflo(b[e]), x2h = bfhi(b[e]);
                const float c0 = t[4 * e], s0 = t[4 * e + 1], c1 = t[4 * e + 2], s1 = t[4 * e + 3];
                ao[e] = pk2(x1l * c0 - x2l * s0, x1h * c1 - x2h * s1);
                bo[e] = pk2(x2l * c0 + x1l * s0, x2h * c1 + x1h * s1);
            }
            qf[8 + 2 * hfi] = __builtin_bit_cast(bf16x8, ao); qf[9 + 2 * hfi] = __builtin_bit_cast(bf16x8, bo);
        }
    }
    f32x16 o[4];
#pragma unroll
    for (int d = 0; d < 4; ++d)
#pragma unroll
        for (int i = 0; i < 16; ++i) o[d][i] = 0.f;
    float mrun = -1e30f, lsum = 0.f;
    const int skey = tid >> 3, ssub = tid & 7, sd = tid >> 2, svs = tid & 3;
    const bf16* knp = KN + (size_t)(krow0 + skey) * 512 + hh * 128 + ssub * 8;
    const bf16* krp = KR + (size_t)(krow0 + skey) * 64 + ssub * 8;
    const bf16* vtp = VT + (size_t)(hh * 128 + sd) * NKROW + krow0 + svs * 8;
    const unsigned kdst0 = skey * AK_STRIDE + ssub * 16, vdst0 = AV_OFF + sd * AV_STRIDE + svs * 16;
    u32x4 pk[3], pv[2];
#define ATT_LOAD(kt_) do { const bf16* a_ = knp + (size_t)(kt_) * (64 * 512); pk[0] = *(const u32x4*)a_; pk[1] = *(const u32x4*)(a_ + 64); pk[2] = *(const u32x4*)(krp + (size_t)(kt_) * (64 * 64)); \
                           const bf16* v_ = vtp + (kt_) * 64; pv[0] = *(const u32x4*)v_; pv[1] = *(const u32x4*)(v_ + 32); } while (0)
#define ATT_WRITE(st_) do { LAS unsigned char* b_ = lds + (st_) * A_STAGE; *(LAS u32x4*)(b_ + kdst0) = pk[0]; *(LAS u32x4*)(b_ + kdst0 + 128) = pk[1]; *(LAS u32x4*)(b_ + kdst0 + 256) = pk[2]; \
                            *(LAS u32x4*)(b_ + vdst0) = pv[0]; *(LAS u32x4*)(b_ + vdst0 + 64) = pv[1]; } while (0)
    __syncthreads();
    ATT_LOAD(0); ATT_WRITE(0);
    if (nkt > 1) ATT_LOAD(1);
    __syncthreads();
    for (int kt = 0; kt < nkt; ++kt) {
        const int cur = kt & 1;
        if (kt + 1 < nkt) { ATT_WRITE(cur ^ 1); if (kt + 2 < nkt) ATT_LOAD(kt + 2); }
        const LAS unsigned char* stg = lds + cur * A_STAGE;
        f32x16 s;
#pragma unroll
        for (int i = 0; i < 16; ++i) s[i] = 0.f;
        {
            const LAS unsigned char* kp = stg + (32 * kh + r) * AK_STRIDE + 16 * hf;
            bf16x8 ka[4], kb[4];
#pragma unroll
            for (int i = 0; i < 4; ++i) ka[i] = *(const LAS bf16x8*)(kp + 32 * i);
#pragma unroll
            for (int i = 0; i < 4; ++i) kb[i] = *(const LAS bf16x8*)(kp + 32 * (4 + i));
            __builtin_amdgcn_sched_barrier(0);
#pragma unroll
            for (int i = 0; i < 4; ++i) s = MFMA32(ka[i], qf[i], s);
#pragma unroll
            for (int i = 0; i < 4; ++i) ka[i] = *(const LAS bf16x8*)(kp + 32 * (8 + i));
            __builtin_amdgcn_sched_barrier(0);
#pragma unroll
            for (int i = 0; i < 4; ++i) s = MFMA32(kb[i], qf[4 + i], s);
#pragma unroll
            for (int i = 0; i < 4; ++i) s = MFMA32(ka[i], qf[8 + i], s);
        }
        const LAS unsigned char* vbase = stg + AV_OFF + r * AV_STRIDE + (32 * kh + 4 * hf) * 2;
        s16x4 vlo[4], vhi[4];
#pragma unroll
        for (int d = 0; d < 4; ++d) { vlo[d] = *(const LAS s16x4*)(vbase + 32 * d * AV_STRIDE); vhi[d] = *(const LAS s16x4*)(vbase + 32 * d * AV_STRIDE + 16); }
        __builtin_amdgcn_sched_barrier(0);
        float mx = s[0];
#pragma unroll
        for (int i = 1; i < 16; ++i) mx = fmaxf(mx, s[i]);
        mx = fmaxf(mx, __shfl_xor(mx, 32));
        const float mnew = fmaxf(mrun, mx), alpha = __builtin_amdgcn_exp2f(mrun - mnew); mrun = mnew;
        float ps = 0.f;
#pragma unroll
        for (int i = 0; i < 16; ++i) { s[i] = __builtin_amdgcn_exp2f(s[i] - mnew); ps += s[i]; }
        lsum = lsum * alpha + ps;
#pragma unroll
        for (int d = 0; d < 4; ++d)
#pragma unroll
            for (int i = 0; i < 16; ++i) o[d][i] *= alpha;
        {
            u32x4 pw; pw.x = pk2(s[0], s[1]); pw.y = pk2(s[2], s[3]); pw.z = pk2(s[4], s[5]); pw.w = pk2(s[6], s[7]);
            const bf16x8 pf = __builtin_bit_cast(bf16x8, pw);
            bf16x8 vf[4];
#pragma unroll
            for (int d = 0; d < 4; ++d) vf[d] = __builtin_shufflevector(vlo[d], vhi[d], 0, 1, 2, 3, 4, 5, 6, 7);
#pragma unroll
            for (int d = 0; d < 4; ++d) { vlo[d] = *(const LAS s16x4*)(vbase + 32 * d * AV_STRIDE + 32); vhi[d] = *(const LAS s16x4*)(vbase + 32 * d * AV_STRIDE + 48); }
            __builtin_amdgcn_sched_barrier(0);
#pragma unroll
            for (int d = 0; d < 4; ++d) o[d] = MFMA32(vf[d], pf, o[d]);
        }
        {
            u32x4 pw; pw.x = pk2(s[8], s[9]); pw.y = pk2(s[10], s[11]); pw.z = pk2(s[12], s[13]); pw.w = pk2(s[14], s[15]);
            const bf16x8 pf = __builtin_bit_cast(bf16x8, pw);
#pragma unroll
            for (int d = 0; d < 4; ++d) { const bf16x8 vf = __builtin_shufflevector(vlo[d], vhi[d], 0, 1, 2, 3, 4, 5, 6, 7); o[d] = MFMA32(vf, pf, o[d]); }
        }
        __syncthreads();
    }
#undef ATT_LOAD
#undef ATT_WRITE
    lsum += __shfl_xor(lsum, 32);
    LAS float* Mg = (LAS float*)lds + rg * 4096; LAS float* ml = (LAS float*)(lds + 65536) + rg * 128;
    if (kh == 1) {
#pragma unroll
        for (int d = 0; d < 4; ++d)
#pragma unroll
            for (int i = 0; i < 16; ++i) Mg[(d * 16 + i) * 64 + lane] = o[d][i];
        ml[lane] = mrun; ml[64 + lane] = lsum;
    }
    __syncthreads();
    if (kh == 0) {
        const float m1 = ml[lane], l1 = ml[64 + lane], m = fmaxf(mrun, m1), a0 = __builtin_amdgcn_exp2f(mrun - m), a1 = __builtin_amdgcn_exp2f(m1 - m);
        const float inv = 1.f / (lsum * a0 + l1 * a1), w0 = a0 * inv, w1 = a1 * inv;
        bf16* op = MIX + (size_t)(qrow0 + 32 * rg + r) * 1024 + hh * 128 + 4 * hf;
#pragma unroll
        for (int d = 0; d < 4; ++d)
#pragma unroll
            for (int ig = 0; ig < 4; ++ig) { float v[4];
#pragma unroll
                for (int e = 0; e < 4; ++e) v[e] = o[d][4 * ig + e] * w0 + Mg[(d * 16 + 4 * ig + e) * 64 + lane] * w1;
                u32x2 w; w.x = pk2(v[0], v[1]); w.y = pk2(v[2], v[3]); *(u32x2*)(op + 32 * d + 8 * ig) = w; }
    }
}

constexpr int SS = 272;
constexpr int S_BS = 0, S_CS = 34816, S_BT = 69632, S_XT = 104448, S_SB = 121856, S_ACS = 139264, S_DT = 139776;
DI void ssd_item(LAS unsigned char* lds, const bf16* XS, const float* DT, const float* a_log, const float* st_in, float* st_out, bf16* Y, int row0, int L, int h, int dir) {
    const int tid = threadIdx.x, lane = tid & 63, wave = tid >> 6, r = lane & 31, hf = lane >> 5, pt = wave & 1, lt = (wave < 4) ? (wave >> 1) : (3 - ((wave - 4) >> 1));
    const int grp = h >> 2;
    const float a = -expf(a_log[dir * 8 + h]);
    LAS float* acs = (LAS float*)(lds + S_ACS); LAS float* dts = (LAS float*)(lds + S_DT);
    f32x16 S;
#pragma unroll
    for (int i = 0; i < 16; ++i) S[i] = st_in ? st_in[(size_t)(32 * pt + crow(i, hf)) * 128 + 32 * lt + r] : 0.f;
    const int nch = L >> 7;
    u32x4 vb[4], vc[4], vx[2]; float d0 = 0.f, d1 = 0.f;
    const int pcol = tid & 15, prow = tid >> 4, xcol = tid & 7, xrow = tid >> 3;
#define SSD_LOAD(ch_) do { \
        _Pragma("unroll") for (int k = 0; k < 4; ++k) { const int i0 = 128 * (ch_) + prow + 32 * k, t = dir ? (L - 1 - i0) : i0; \
            const bf16* rpb = XS + (size_t)(row0 + t) * 1024 + 512 + grp * 128 + 8 * pcol; vb[k] = *(const u32x4*)rpb; vc[k] = *(const u32x4*)(rpb + 256); } \
        _Pragma("unroll") for (int k = 0; k < 2; ++k) { const int i0 = 128 * (ch_) + xrow + 64 * k, t = dir ? (L - 1 - i0) : i0; \
            vx[k] = *(const u32x4*)(XS + (size_t)(row0 + t) * 1024 + h * 64 + 8 * xcol); } \
        if (wave == 0) { const int i0 = 128 * (ch_) + 2 * lane, t0 = dir ? (L - 1 - i0) : i0, t1 = dir ? (t0 - 1) : (t0 + 1); \
            d0 = DT[(size_t)(row0 + t0) * 16 + dir * 8 + h]; d1 = DT[(size_t)(row0 + t1) * 16 + dir * 8 + h]; } } while (0)
    for (int ch = 0; ch < nch; ++ch) {
        SSD_LOAD(ch);
        __syncthreads();
        if (wave == 0) {
            const float x0 = d0 * a, x1 = d1 * a; float v = x0 + x1;
#pragma unroll
            for (int o = 1; o < 64; o <<= 1) { const float n = __shfl_up(v, o); if (lane >= o) v += n; }
            acs[2 * lane] = v - x1; acs[2 * lane + 1] = v; dts[2 * lane] = d0; dts[2 * lane + 1] = d1;
        }
#pragma unroll
        for (int i = 0; i < 16; ++i) *(LAS unsigned short*)(lds + S_SB + (32 * pt + crow(i, hf)) * SS + (32 * lt + r) * 2) = f2bf1(S[i]);
        __syncthreads();
        const float acs_last = acs[127];
#pragma unroll
        for (int k = 0; k < 4; ++k) { const int l = prow + 32 * k;
            *(LAS u32x4*)(lds + S_BS + l * SS + pcol * 16) = vb[k]; *(LAS u32x4*)(lds + S_CS + l * SS + pcol * 16) = vc[k];
            const float wB = __expf(acs_last - acs[l]);
            LAS unsigned char* colb = lds + S_BT + (8 * pcol) * SS + ((((l >> 3) ^ pcol) << 3) + (l & 7)) * 2;
#pragma unroll
            for (int e = 0; e < 4; ++e) { const unsigned u = pk2(bflo(vb[k][e]) * wB, bfhi(vb[k][e]) * wB);
                *(LAS unsigned short*)(colb + (2 * e) * SS) = (unsigned short)(u & 0xffffu);
                *(LAS unsigned short*)(colb + (2 * e + 1) * SS) = (unsigned short)(u >> 16); } }
#pragma unroll
        for (int k = 0; k < 2; ++k) { const int l = xrow + 64 * k; const float wX = dts[l];
            LAS unsigned char* colb = lds + S_XT + (8 * xcol) * SS + ((((l >> 3) ^ xcol) << 3) + (l & 7)) * 2;
#pragma unroll
            for (int e = 0; e < 4; ++e) { const unsigned u = pk2(bflo(vx[k][e]) * wX, bfhi(vx[k][e]) * wX);
                *(LAS unsigned short*)(colb + (2 * e) * SS) = (unsigned short)(u & 0xffffu);
                *(LAS unsigned short*)(colb + (2 * e + 1) * SS) = (unsigned short)(u >> 16); } }
        __syncthreads();
        bf16x8 cf[8];
#pragma unroll
        for (int ks = 0; ks < 8; ++ks) cf[ks] = *(const LAS bf16x8*)(lds + S_CS + (32 * lt + r) * SS + (16 * ks + 8 * hf) * 2);
        const float acs_l = acs[32 * lt + r]; const int lcol = 32 * lt + r;
        const int cX = (4 * pt + (r >> 3)) & 7, cB = (4 * lt + (r >> 3)) & 15;
        f32x16 Yd;
#pragma unroll
        for (int i = 0; i < 16; ++i) Yd[i] = 0.f;
        for (int st = 0; st <= lt; ++st) {
            f32x16 cb;
#pragma unroll
            for (int i = 0; i < 16; ++i) cb[i] = 0.f;
            { bf16x8 bfr[8]; const LAS unsigned char* bp = lds + S_BS + (32 * st + r) * SS + 16 * hf;
#pragma unroll
              for (int ks = 0; ks < 8; ++ks) bfr[ks] = *(const LAS bf16x8*)(bp + 32 * ks);
              __builtin_amdgcn_sched_barrier(0);
#pragma unroll
              for (int ks = 0; ks < 8; ++ks) cb = MFMA32(bfr[ks], cf[ks], cb); }
            s16x4 xlo[2], xhi[2]; float av[16];
#pragma unroll
            for (int u = 0; u < 2; ++u) { const LAS unsigned char* xp = lds + S_XT + (32 * pt + r) * SS + 8 * hf; const int lg = 4 * st + 2 * u;
                xlo[u] = *(const LAS s16x4*)(xp + ((lg ^ cX) << 4)); xhi[u] = *(const LAS s16x4*)(xp + (((lg + 1) ^ cX) << 4)); }
#pragma unroll
            for (int i = 0; i < 16; ++i) av[i] = acs[32 * st + crow(i, hf)];
#pragma unroll
            for (int i = 0; i < 16; ++i) { const int sidx = 32 * st + crow(i, hf); const float e = __expf(acs_l - av[i]); cb[i] = (sidx <= lcol) ? cb[i] * e : 0.f; }
#pragma unroll
            for (int u = 0; u < 2; ++u) {
                u32x4 pw; pw.x = pk2(cb[8 * u], cb[8 * u + 1]); pw.y = pk2(cb[8 * u + 2], cb[8 * u + 3]); pw.z = pk2(cb[8 * u + 4], cb[8 * u + 5]); pw.w = pk2(cb[8 * u + 6], cb[8 * u + 7]);
                const bf16x8 pf = __builtin_bit_cast(bf16x8, pw);
                const bf16x8 xa = __builtin_shufflevector(xlo[u], xhi[u], 0, 1, 2, 3, 4, 5, 6, 7);
                Yd = MFMA32(xa, pf, Yd);
            }
        }
        f32x16 Yo;
#pragma unroll
        for (int i = 0; i < 16; ++i) Yo[i] = 0.f;
        { bf16x8 sa[8]; const LAS unsigned char* sp = lds + S_SB + (32 * pt + r) * SS + 16 * hf;
#pragma unroll
          for (int ks = 0; ks < 8; ++ks) sa[ks] = *(const LAS bf16x8*)(sp + 32 * ks);
          __builtin_amdgcn_sched_barrier(0);
#pragma unroll
          for (int ks = 0; ks < 8; ++ks) Yo = MFMA32(sa[ks], cf[ks], Yo); }
        { const float el = __expf(acs_l); const int i0 = 128 * ch + lcol, t = dir ? (L - 1 - i0) : i0;
          bf16* yp = Y + (size_t)(row0 + t) * 512 + h * 64 + 32 * pt + 4 * hf;
#pragma unroll
          for (int ig = 0; ig < 4; ++ig) { u32x2 v; v.x = pk2(Yd[4 * ig] + el * Yo[4 * ig], Yd[4 * ig + 1] + el * Yo[4 * ig + 1]); v.y = pk2(Yd[4 * ig + 2] + el * Yo[4 * ig + 2], Yd[4 * ig + 3] + el * Yo[4 * ig + 3]);
              *(u32x2*)(yp + 8 * ig) = v; } }
        { const float dl = __expf(acs_last);
#pragma unroll
          for (int i = 0; i < 16; ++i) S[i] *= dl;
          const LAS unsigned char* xp2 = lds + S_XT + (32 * pt + r) * SS; const LAS unsigned char* bp2 = lds + S_BT + (32 * lt + r) * SS;
#pragma unroll
          for (int half = 0; half < 2; ++half) { bf16x8 xa[4], bb[4];
#pragma unroll
              for (int k = 0; k < 4; ++k) { const int lg = 2 * (4 * half + k) + hf; xa[k] = *(const LAS bf16x8*)(xp2 + ((lg ^ cX) << 4)); bb[k] = *(const LAS bf16x8*)(bp2 + ((lg ^ cB) << 4)); }
              __builtin_amdgcn_sched_barrier(0);
#pragma unroll
              for (int k = 0; k < 4; ++k) S = MFMA32(xa[k], bb[k], S); } }
    }
#undef SSD_LOAD
    if (st_out) {
#pragma unroll
        for (int i = 0; i < 16; ++i) st_out[(size_t)(32 * pt + crow(i, hf)) * 128 + 32 * lt + r] = S[i];
    }
}

DI void phase5(LAS unsigned char* lds, const float* const* in, float* out, unsigned char* ws, int G) {
    const bf16* Q = (const bf16*)(ws + WS_Q); const bf16* KN = (const bf16*)(ws + WS_KN); const bf16* KR = (const bf16*)(ws + WS_KR); const bf16* VT = (const bf16*)(ws + WS_VT);
    bf16* MIX = (bf16*)(ws + WS_MIX);
    const int bxl = (int)blockIdx.x, vb = (G == 256) ? ((bxl & 7) * 32 + (bxl >> 3)) : bxl;
    for (int u = vb; u < 512; u += G) {
        if (u < 256) { const int b = u >> 5, hh = (u >> 3) & 3, qb = u & 7; attn_unit(lds, Q, KN, KR, VT, MIX, (const float*)(ws + WS_ROPE), NCTX + b * 1024 + qb * 128, NCTX + b * 1280, 20, hh); }
        else { const int v = u - 256, b = v >> 3, hh = (v >> 1) & 3, qb = v & 1; attn_unit(lds, Q, KN, KR, VT, MIX, nullptr, b * 256 + qb * 128, b * 256, 4, hh); }
    }
    const bf16* XS = (const bf16*)(ws + WS_XS); const float* DT = (const float*)(ws + WS_DT); const float* a_log = in[19];
    bf16* YF = (bf16*)(ws + WS_YF); bf16* YB = (bf16*)(ws + WS_YB);
    float* out_st = out + 2 * (size_t)NCTX * DM + (size_t)NCTX * 256 + (size_t)NCTX * 64;
    const int vs = (G == 256) ? (((bxl >> 3) < 16) ? ((bxl & 7) * 16 + (bxl >> 3)) : (128 + (bxl & 7) * 16 + (bxl >> 3) - 16)) : bxl;
    for (int s = vs; s < 256; s += G) {
        if (s < 128) { const int b = s >> 4, h = (s >> 1) & 7, dir = s & 1;
            ssd_item(lds, XS, DT, a_log, in[4] + ((size_t)(b * 2 + dir) * 8 + h) * 8192, nullptr, dir ? YB : YF, NCTX + b * 1024, 1024, h, dir); }
        else { for (int k = 0; k < 4; ++k) { const int it = (s - 128) * 4 + k, b = it >> 4, h = (it >> 1) & 7, dir = it & 1;
            ssd_item(lds, XS, DT, a_log, nullptr, out_st + ((size_t)(b * 2 + dir) * 8 + h) * 8192, dir ? YB : YF, b * 256, 256, h, dir); } }
    }
}

#define XB_TMO      128
#define XB_XCNT(j)  (256  + 64 * (j))
#define XB_XSUB(j)  (1280 + 64 * (j))
#define XB_XGEN(j)  (2304 + 64 * (j))
#define XB_TOP      3328
#define XB_TOPGEN   3392
#define XCD_BAR_WORDS 3456
#define XB_SPIN_CAP (1u << 18)
__device__ __forceinline__ unsigned xb_ld(unsigned* p)              { return __hip_atomic_load(p, __ATOMIC_RELAXED, __HIP_MEMORY_SCOPE_AGENT); }
__device__ __forceinline__ unsigned xb_add(unsigned* p, unsigned v) { return __hip_atomic_fetch_add(p, v, __ATOMIC_RELAXED, __HIP_MEMORY_SCOPE_AGENT); }
__device__ __forceinline__ unsigned xb_xcc_id() { return (unsigned)__builtin_amdgcn_s_getreg((3 << 11) | 20) & 0xFu; }
#define XB_SPIN(cond, bar) do { unsigned _sp = 0; while (cond) { __builtin_amdgcn_s_sleep(1); \
    if ((++_sp & 255u) == 0u) { if (xb_ld(&(bar)[XB_TMO])) break; if (_sp > XB_SPIN_CAP) { atomicAdd(&(bar)[XB_TMO], 1u); break; } } } } while (0)
struct XcdBarrier { unsigned* bar; unsigned x; volatile LAS unsigned* st; };
__device__ __forceinline__ XcdBarrier xcd_barrier_post(unsigned* bar, volatile LAS unsigned* st) {
    XcdBarrier b; b.bar = bar; b.x = xb_xcc_id(); b.st = st;
    if (threadIdx.x == 0) (void)xb_add(&bar[XB_XCNT(b.x)], 1u);
    return b;
}
__device__ __forceinline__ void xcd_barrier_complete(unsigned* bar, unsigned x, unsigned& nloc, unsigned& nx) {
    const unsigned G = gridDim.x * gridDim.y * gridDim.z;
    unsigned sum, cnt, mine, sp = 0u;
    for (;;) {
        sum = 0u; cnt = 0u; mine = 0u;
#pragma unroll
        for (unsigned j = 0; j < 16; ++j) { const unsigned c = xb_ld(&bar[XB_XCNT(j)]); sum += c; cnt += (c > 0u) ? 1u : 0u; mine = (j == x) ? c : mine; }
        if (sum == G) break;
        __builtin_amdgcn_s_sleep(1);
        if ((++sp & 255u) == 0u) { if (xb_ld(&bar[XB_TMO])) break; if (sp > XB_SPIN_CAP) { atomicAdd(&bar[XB_TMO], 1u); break; } }
    }
    nloc = mine > 0u ? mine : 1u; nx = cnt > 0u ? cnt : 1u;
}
__device__ __forceinline__ void xcd_barrier(const XcdBarrier& b) {
    asm volatile("s_waitcnt vmcnt(0)" ::: "memory");
    __syncthreads();
    if (threadIdx.x == 0) {
        unsigned* bar = b.bar;
        __builtin_amdgcn_s_waitcnt(0);
        unsigned nloc = b.st[0], nx = b.st[1];
        if (nloc == 0u) { xcd_barrier_complete(bar, b.x, nloc, nx); b.st[0] = nloc; b.st[1] = nx; }
        const unsigned old = xb_add(&bar[XB_XSUB(b.x)], 1u);
        const unsigned gen = old / nloc;
        if (old + 1u == (gen + 1u) * nloc) {
            __builtin_amdgcn_fence(__ATOMIC_RELEASE, "agent");
            asm volatile("s_waitcnt vmcnt(0)" ::: "memory");
            const unsigned og = xb_add(&bar[XB_TOP], 1u);
            const unsigned tg = og / nx;
            if (og + 1u == (tg + 1u) * nx) xb_add(&bar[XB_TOPGEN], 1u);
            else XB_SPIN(xb_ld(&bar[XB_TOPGEN]) == tg, bar);
            __builtin_amdgcn_fence(__ATOMIC_ACQUIRE, "agent");
            xb_add(&bar[XB_XGEN(b.x)], 1u);
            asm volatile("s_waitcnt vmcnt(0)" ::: "memory");
        } else {
            XB_SPIN(xb_ld(&bar[XB_XGEN(b.x)]) == gen, bar);
            __builtin_amdgcn_fence(__ATOMIC_ACQUIRE, "agent");
            asm volatile("s_waitcnt vmcnt(0)" ::: "memory");
        }
    }
    __syncthreads();
}
constexpr int LDS_BAR_OFF = 147392;
constexpr size_t CTL_ZERO_BYTES = 65536;

constexpr size_t WS_PS1 = 128 * 1024, WS_PS2 = 384 * 1024, WS_PS3 = 640 * 1024;
DI void panel_sumsq(const f32x4 (&acc)[2][2][4][2], LAS float* red, float* PS, const pg8::Unit& u, int wr, int wc, int fr, int fq) {
#pragma unroll
    for (int ai = 0; ai < 2; ++ai)
#pragma unroll
        for (int m = 0; m < 4; ++m) { float s = 0.f;
#pragma unroll
            for (int bj = 0; bj < 2; ++bj)
#pragma unroll
                for (int n = 0; n < 2; ++n)
#pragma unroll
                    for (int i = 0; i < 4; ++i) s += acc[ai][bj][m][n][i] * acc[ai][bj][m][n][i];
            s += __shfl_xor(s, 16); s += __shfl_xor(s, 32);
            if (fq == 0) red[wc * 256 + ai * 128 + wr * 64 + m * 16 + fr] = s; }
    __syncthreads();
    if (threadIdx.x < 256) { const int t = threadIdx.x; PS[u.pn * NTOK + u.pm * 256 + t] = red[t] + red[256 + t] + red[512 + t] + red[768 + t]; }
}
DI void panel_rstd(LAS float* rs, const float* PS, const pg8::Unit& u) {
    if (threadIdx.x < 256) { const int row = u.pm * 256 + threadIdx.x; rs[threadIdx.x] = rsqrtf((PS[row] + PS[NTOK + row] + PS[2 * NTOK + row] + PS[3 * NTOK + row]) * (1.f / DM) + NORM_EPS); }
    __syncthreads();
}
struct EpiMixFused {
    static constexpr bool PERM = true, AFTER_DRAIN = true;
    const float* x0; const float* x1; bf16* Y1; bf16* H; const float* mod; const float* g_post; const float* g_pre; float* PS1; float* PS2; XcdBarrier bar;
    DI void operator()(const f32x4 (&)[2][2][4][2], const pg8::Unit&, int, int, int, int) const {}
    DI void fused(f32x4 (&acc)[2][2][4][2], const pg8::Unit& u, int wr, int wc, int fr, int fq, LAS unsigned char* lds, int wid, int lane) const {
        LAS float* red = (LAS float*)lds; LAS float* rs = (LAS float*)(lds + 4096);
        const int row0 = u.pm * 256 + wr * 64 + fr, col0 = u.pn * 256 + wc * 32 + 8 * fq;
        const float* mj = mod + mod_idx(u.pm * 256) * 6144;
        panel_sumsq(acc, red, PS1, u, wr, wc, fr, fq);
        xcd_barrier(bar);
        panel_rstd(rs, PS1, u);
#pragma unroll
        for (int bj = 0; bj < 2; ++bj) { const int col = col0 + bj * 128;
            const f32x4 ca = *(const f32x4*)(mj + 2048 + col) * *(const f32x4*)(g_post + col), cb = *(const f32x4*)(mj + 2048 + col + 4) * *(const f32x4*)(g_post + col + 4);
#pragma unroll
            for (int ai = 0; ai < 2; ++ai)
#pragma unroll
                for (int m = 0; m < 4; ++m) { const int row = row0 + ai * 128 + m * 16; const float r = rs[ai * 128 + wr * 64 + m * 16 + fr];
                    const float* xr = ((row < NCTX) ? x0 + (size_t)row * DM : x1 + (size_t)(row - NCTX) * DM) + col;
                    const f32x4 y0 = __builtin_nontemporal_load((const f32x4*)xr) + ca * (acc[ai][bj][m][0] * r), y1 = __builtin_nontemporal_load((const f32x4*)(xr + 4)) + cb * (acc[ai][bj][m][1] * r);
                    acc[ai][bj][m][0] = y0; acc[ai][bj][m][1] = y1;
                    st8bf(Y1 + (size_t)row * DM + col, y0, y1); } }
        panel_sumsq(acc, red, PS2, u, wr, wc, fr, fq);
        xcd_barrier(bar);
        panel_rstd(rs, PS2, u);
#pragma unroll
        for (int bj = 0; bj < 2; ++bj) { const int col = col0 + bj * 128;
            const f32x4 ga = *(const f32x4*)(g_pre + col) * (*(const f32x4*)(mj + 4096 + col) + 1.f), gb = *(const f32x4*)(g_pre + col + 4) * (*(const f32x4*)(mj + 4096 + col + 4) + 1.f);
            const f32x4 sa = *(const f32x4*)(mj + 3072 + col), sb = *(const f32x4*)(mj + 3072 + col + 4);
#pragma unroll
            for (int ai = 0; ai < 2; ++ai)
#pragma unroll
                for (int m = 0; m < 4; ++m) { const int row = row0 + ai * 128 + m * 16; const float r = rs[ai * 128 + wr * 64 + m * 16 + fr];
                    st8bf(H + (size_t)row * DM + col, acc[ai][bj][m][0] * r * ga + sa, acc[ai][bj][m][1] * r * gb + sb); } }
    }
};
struct EpiFfnFused {
    static constexpr bool PERM = true, AFTER_DRAIN = true;
    float* out; const bf16* Y1; const float* mod; const float* g_post; float* PS; XcdBarrier bar;
    DI void operator()(const f32x4 (&)[2][2][4][2], const pg8::Unit&, int, int, int, int) const {}
    DI void fused(f32x4 (&acc)[2][2][4][2], const pg8::Unit& u, int wr, int wc, int fr, int fq, LAS unsigned char* lds, int wid, int lane) const {
        LAS float* red = (LAS float*)lds; LAS float* rs = (LAS float*)(lds + 4096);
        const int row0 = u.pm * 256 + wr * 64 + fr, col0 = u.pn * 256 + wc * 32 + 8 * fq;
        const float* mj = mod + mod_idx(u.pm * 256) * 6144;
        panel_sumsq(acc, red, PS, u, wr, wc, fr, fq);
        xcd_barrier(bar);
        panel_rstd(rs, PS, u);
#pragma unroll
        for (int bj = 0; bj < 2; ++bj) { const int col = col0 + bj * 128;
            const f32x4 ca = *(const f32x4*)(mj + 5120 + col) * *(const f32x4*)(g_post + col), cb = *(const f32x4*)(mj + 5120 + col + 4) * *(const f32x4*)(g_post + col + 4);
#pragma unroll
            for (int ai = 0; ai < 2; ++ai)
#pragma unroll
                for (int m = 0; m < 4; ++m) { const int row = row0 + ai * 128 + m * 16; const float r = rs[ai * 128 + wr * 64 + m * 16 + fr];
                    float* o = out + (size_t)row * DM + col; const u32x4 yv = *(const u32x4*)(Y1 + (size_t)row * DM + col);
                    const f32x4 ya = {bflo(yv.x), bfhi(yv.x), bflo(yv.y), bfhi(yv.y)}, yb = {bflo(yv.z), bfhi(yv.z), bflo(yv.w), bfhi(yv.w)};
                    __builtin_nontemporal_store(ya + ca * (acc[ai][bj][m][0] * r), (f32x4*)o); __builtin_nontemporal_store(yb + cb * (acc[ai][bj][m][1] * r), (f32x4*)(o + 4)); } }
    }
};

struct Args { const float* in[28]; float* out; unsigned char* ws; int ph_lo, ph_hi; };
constexpr int NPHASE = 12;

__global__ void __launch_bounds__(512, 2) mk_fwd(Args args) {
    extern __shared__ __attribute__((aligned(16))) unsigned char lds_raw[];
    LAS unsigned char* lds = (LAS unsigned char*)lds_raw;
    const int G = gridDim.x, bx = blockIdx.x;
    unsigned char* ws = args.ws; float* out = args.out; const float* const* in = args.in;
    const int lo = args.ph_lo, hi = args.ph_hi;
    if (lo < 0) cg::this_grid().sync();
    volatile LAS unsigned* bst = (volatile LAS unsigned*)(lds + LDS_BAR_OFF);
    if (threadIdx.x < 2) bst[threadIdx.x] = 0u;
    __syncthreads();
    XcdBarrier bar; bar.bar = (unsigned*)ws; bar.x = 0; bar.st = bst;
    if (hi - lo > 1) bar = xcd_barrier_post((unsigned*)ws, bst);
#ifndef P4SEL
#define P4SEL 7
#endif
#ifndef DUPMASK
#define DUPMASK 0
#endif
#define REP(k) for (int rep_ = 0; rep_ < 1 + ((DUPMASK >> (k)) & 1); ++rep_)
#ifndef PHMASK
#define PHMASK 0xfff
#endif
#define IN(k) (((PHMASK >> (k)) & 1) && lo <= (k) && (k) < hi)
#define SEAM(k) do { if (hi - lo > 1) { xcd_barrier(bar); } } while (0)
    typedef pg8::StaticOrder SO;
    if (IN(0)) REP(0) { phase0(lds, in, ws, G); __syncthreads(); }
    SEAM(0);
    if (IN(1)) REP(1) phase1(in, ws, G);
    SEAM(1);
    if (IN(2)) REP(2) {
        __syncthreads();
        pg8::Gemm g{(const bf16*)(ws + WS_H), (const bf16*)(ws + WS_WIN), NTOK, IN_WP, 1024}; SO S; S.init(NTOK, IN_WP, G, bx);
        Epi8<FInProj> E{{(bf16*)(ws + WS_PA), (bf16*)(ws + WS_Z), (bf16*)(ws + WS_XBC), (float*)(ws + WS_DTR)}};
        pg8::gemm_phase<Epi8<FInProj>, SO, true, true>(lds, g, S, E);
        if (G == 256) { if (bx >= 64) ffn_weight_copies(lds, in, ws, (bx - 64) * 8 + (int)(threadIdx.x >> 6), 192 * 8); }
        else ffn_weight_copies(lds, in, ws, bx * 8 + (int)(threadIdx.x >> 6), G * 8);
    }
    SEAM(2);
    if (IN(3)) REP(3) phase3(in, out, ws, G);
    SEAM(3);
    if (IN(4)) REP(4) {
        __syncthreads();
#if P4SEL & 1
        { pg8::Gemm g{(const bf16*)(ws + WS_QN), (const bf16*)(ws + WS_WUQ), NTOK, 768, 384}; SO S; S.init(NTOK, 768, G, bx);
          Epi8<FQUp> E{{(bf16*)(ws + WS_Q)}};
          pg8::gemm_phase<Epi8<FQUp>, SO, true, true>(lds, g, S, E); }
#endif
#if P4SEL & 2
        __syncthreads();
        { pg8::Gemm g{(const bf16*)(ws + WS_CKV), (const bf16*)(ws + WS_WKN), NKROW, 512, 256}; SO S; S.init(NKROW, 512, G, (bx + 64) % G);
          Epi8<FBf> E{{(bf16*)(ws + WS_KN), 512}};
          pg8::gemm_phase<Epi8<FBf>, SO, true, true>(lds, g, S, E); }
#endif
#if P4SEL & 4
        __syncthreads();
        { pg8::Gemm g{(const bf16*)(ws + WS_WV), (const bf16*)(ws + WS_CKV), 512, NKROW, 256}; SO S; S.init(512, NKROW, G, (bx + 176) % G);
          Epi8<FBf> E{{(bf16*)(ws + WS_VT), NKROW}};
          pg8::gemm_phase<Epi8<FBf>, SO, true, true>(lds, g, S, E); }
#endif
    }
    SEAM(4);
    if (IN(5)) phase5(lds, in, out, ws, G);
    SEAM(5);
    if (IN(6)) REP(6) phase6(in, ws, G);
    SEAM(6);
    if (IN(7)) {
        pg8::Gemm g{(const bf16*)(ws + WS_MIX), (const bf16*)(ws + WS_WOUT), NTOK, 1024, 1024}; SO S; S.init(NTOK, 1024, G, bx);
        EpiMixFused E{in[0], in[1], (bf16*)(ws + WS_Y1), (bf16*)(ws + WS_H), (const float*)(ws + WS_MOD), in[10], in[23], (float*)(ws + WS_PS1), (float*)(ws + WS_PS2), bar};
        pg8::gemm_phase<EpiMixFused, SO, false, true>(lds, g, S, E);
    }
    SEAM(7);
    if (IN(9)) REP(9) {
        __syncthreads();
        pg8::Gemm g{(const bf16*)(ws + WS_H), (const bf16*)(ws + WS_WGU), NTOK, 2 * DFF, 1024}; SO S; S.init(NTOK, 2 * DFF, G, bx);
        EpiGateUp E{(bf16*)(ws + WS_ACT)};
        pg8::gemm_phase<EpiGateUp, SO, true, true>(lds, g, S, E);
    }
    SEAM(9);
    if (IN(10)) {
        pg8::Gemm g{(const bf16*)(ws + WS_ACT), (const bf16*)(ws + WS_WDN), NTOK, 1024, DFF}; SO S; S.init(NTOK, 1024, G, bx);
        EpiFfnFused E{out, (const bf16*)(ws + WS_Y1), (const float*)(ws + WS_MOD), in[24], (float*)(ws + WS_PS3), bar};
        pg8::gemm_phase<EpiFfnFused, SO, false, true>(lds, g, S, E);
    }
#undef IN
#undef SEAM
}

extern "C" void kernel_launch(void* const* d_in, const int* in_sizes, int n_in, void* d_out, int out_size, void* d_ws, size_t ws_size, hipStream_t stream) {
    static int grid = 0;
    if (grid == 0) {
        int dev = 0, cus = 0, per_cu = 0;
        if (hipGetDevice(&dev) != hipSuccess || hipDeviceGetAttribute(&cus, hipDeviceAttributeMultiprocessorCount, dev) != hipSuccess) { fprintf(stderr, "kernel_launch: device query failed\n"); grid = -1; return; }
        if (hipFuncSetAttribute((const void*)mk_fwd, hipFuncAttributeMaxDynamicSharedMemorySize, LDS_BYTES) != hipSuccess) { fprintf(stderr, "kernel_launch: hipFuncSetAttribute failed\n"); grid = -1; return; }
        if (hipOccupancyMaxActiveBlocksPerMultiprocessor(&per_cu, (const void*)mk_fwd, 512, LDS_BYTES) != hipSuccess || per_cu < 1) { fprintf(stderr, "kernel_launch: occupancy query says %d blocks/CU\n", per_cu); grid = -1; return; }
        grid = cus;
        if (cus != 256) { fprintf(stderr, "kernel_launch: built for a 256-CU device (one 256x256 GEMM unit per workgroup in the fused-norm phases), got %d CUs\n", cus); grid = -1; return; }
        if (n_in != 28 || ws_size < 252 * MiB) { fprintf(stderr, "kernel_launch: unexpected n_in %d / ws %zu\n", n_in, ws_size); grid = -1; return; }
    }
    if (grid < 0) return;
    if (hipMemsetAsync(d_ws, 0, CTL_ZERO_BYTES, stream) != hipSuccess) { fprintf(stderr, "kernel_launch: memset failed\n"); return; }
    Args a{};
    for (int i = 0; i < 28; ++i) a.in[i] = (const float*)d_in[i];
    a.out = (float*)d_out; a.ws = (unsigned char*)d_ws;
    void* kargs[] = {&a};
#ifndef PROBE_HI
#define PROBE_HI 0
#endif
#if PROBE_HI > 0
    a.ph_lo = 0; a.ph_hi = PROBE_HI;
    (void)hipLaunchCooperativeKernel((const void*)mk_fwd, dim3(grid), dim3(512), kargs, LDS_BYTES, stream);
    (void)hipMemsetAsync(d_ws, 0, CTL_ZERO_BYTES, stream);
#endif
    a.ph_lo = 0; a.ph_hi = NPHASE;
    hipError_t e = hipLaunchCooperativeKernel((const void*)mk_fwd, dim3(grid), dim3(512), kargs, LDS_BYTES, stream);
    if (e != hipSuccess) fprintf(stderr, "kernel_launch: cooperative launch failed: %s (grid %d)\n", hipGetErrorString(e), grid);
}
```

```cpp
#include <hip/hip_runtime.h>
#include <hip/hip_cooperative_groups.h>
#include <cstdio>
#include <cstdint>
namespace cg = cooperative_groups;

#ifndef MK_SPLIT
#define MK_SPLIT 0
#endif

#define DI __device__ __forceinline__
#define LAS __attribute__((address_space(3)))
typedef unsigned short bf16;
typedef float f32x4 __attribute__((ext_vector_type(4)));
typedef float f32x16 __attribute__((ext_vector_type(16)));
typedef short bf16x8 __attribute__((ext_vector_type(8)));
typedef short s16x4 __attribute__((ext_vector_type(4)));
typedef unsigned u32x4 __attribute__((ext_vector_type(4)));
typedef unsigned u32x2 __attribute__((ext_vector_type(2)));
typedef float f32x2_t __attribute__((ext_vector_type(2)));

namespace pg8 {
#define PG8_LAS __attribute__((address_space(3)))
typedef unsigned short bf16_t;
typedef short bf16x8 __attribute__((ext_vector_type(8)));
typedef float f32x4 __attribute__((ext_vector_type(4)));
typedef unsigned u32x4 __attribute__((ext_vector_type(4)));
constexpr int BM = 256, BK = 64, HALF = 128, HTB = HALF * BK * 2, STAGE_BYTES = 8 * HTB, NXCD = 8, WGM = 8;

__host__ __device__ __forceinline__ int lds_byte(int r, int c) { const int st = (r >> 4) * 2 + (c >> 5), rr = r & 15, cc = c & 31, ob = rr * 64 + cc * 2; return st * 1024 + (ob ^ (((ob >> 9) & 1) << 5)); }
__host__ __device__ __forceinline__ void stage_rc(int b, int& R, int& C) { const int st = b / 1024, sb = b % 1024, swz = sb ^ (((sb >> 9) & 1) << 5); R = (st >> 1) * 16 + swz / 64; C = (st & 1) * 32 + (swz % 64) / 2; }
__host__ __device__ __forceinline__ int perm32(int rho) { const int n = rho >> 4, i = rho & 15; return 8 * (i >> 2) + 4 * n + (i & 3); }

struct Unit { int pm, pn; };
struct Gemm { const bf16_t* A; const bf16_t* Bt; int M, N, K; };

struct StaticOrder {
    int nM, nN, nwg, G, c;
    __host__ __device__ void init(int M, int N, int G_, int c_) { nM = M / BM; nN = N / BM; nwg = nM * nN; G = G_; c = c_; }
    __host__ __device__ bool next(int i, Unit& u) const {
        const long L = (long)i * G + c; if (L >= nwg) return false;
        int wgid = (int)L; { const int q = nwg / NXCD, r = nwg % NXCD, xcd = wgid % NXCD, off = wgid / NXCD; wgid = (xcd < r ? xcd * (q + 1) : r * (q + 1) + (xcd - r) * q) + off; }
        const int nig = WGM * nN, gid = wgid / nig, fm = gid * WGM, gsz = (nM - fm) < WGM ? (nM - fm) : WGM;
        u.pm = fm + ((wgid % nig) % gsz); u.pn = (wgid % nig) / gsz; return true;
    }
    __device__ __forceinline__ void a_ready(const Unit&) const {}
    __device__ __forceinline__ void done(const Unit&) const {}
};

template <class Epi, class Sched, bool ALIGN_EPI = false, bool SP2 = false>
__device__ __forceinline__ void gemm_phase(PG8_LAS unsigned char* lds, const Gemm g, const Sched& S, const Epi& E) {
    const int tid = threadIdx.x, wid = __builtin_amdgcn_readfirstlane(tid >> 6), lane = tid & 63, wr = wid >> 2, wc = wid & 3, fr = lane & 15, fq = lane >> 4;
    int Kop = g.K; asm volatile("" : "+s"(Kop));
    const int K = Kop, nt = K / BK;
    unsigned voffA[2], voffB[2];
#pragma unroll
    for (int i = 0; i < 2; ++i) { int R, C; stage_rc(tid * 16 + i * 8192, R, C); const int Rb = Epi::PERM ? ((R & ~31) + perm32(R & 31)) : R;
        voffA[i] = (unsigned)(R * K + C) * 2u; voffB[i] = (unsigned)(Rb * K + C) * 2u; }
    const size_t kstep = (size_t)(BK * 2);
    const size_t hstep = (size_t)HALF * K * 2;
    const size_t tstep = 2 * hstep;
    const unsigned ldsw = (unsigned)wid * 1024u;
    const int aoff = lds_byte(wr * 64 + fr, fq * 8), boff = lds_byte(wc * 32 + fr, fq * 8);
#define PG8_SA(b, h) (((b) * 2 + (h)) * HTB)
#define PG8_SB(b, h) ((4 + (b) * 2 + (h)) * HTB)
#define PG8_STAGE(bufoff, gbase, voff) do { _Pragma("unroll") for (int _i = 0; _i < 2; ++_i) \
        __builtin_amdgcn_global_load_lds((const unsigned*)((const char*)(gbase) + (voff)[_i]), (PG8_LAS unsigned*)(lds + (bufoff) + ldsw + _i * 8192), 16, 0, 0); } while (0)
#define PG8_LDA(dst, b, h) do { _Pragma("unroll") for (int m = 0; m < 4; ++m) _Pragma("unroll") for (int k = 0; k < 2; ++k) dst[m][k] = *(const PG8_LAS bf16x8*)(lds + PG8_SA(b, h) + aoff + m * 2048 + k * 1024); } while (0)
#define PG8_LDB(dst, b, h) do { _Pragma("unroll") for (int n = 0; n < 2; ++n) _Pragma("unroll") for (int k = 0; k < 2; ++k) dst[n][k] = *(const PG8_LAS bf16x8*)(lds + PG8_SB(b, h) + boff + n * 2048 + k * 1024); } while (0)
#define PG8_MMA(ai, bj, At, Bt) do { __builtin_amdgcn_s_setprio(1); _Pragma("unroll") for (int m = 0; m < 4; ++m) _Pragma("unroll") for (int n = 0; n < 2; ++n) _Pragma("unroll") for (int k = 0; k < 2; ++k) \
        acc[ai][bj][m][n] = __builtin_amdgcn_mfma_f32_16x16x32_bf16(Bt[n][k], At[m][k], acc[ai][bj][m][n], 0, 0, 0); __builtin_amdgcn_s_setprio(0); } while (0)
#define PG8_WAIT_V(n) asm volatile("s_waitcnt vmcnt(" #n ")" ::: "memory")
#define PG8_WAIT_L(n) asm volatile("s_waitcnt lgkmcnt(" #n ")" ::: "memory")
#define PG8_BAR __builtin_amdgcn_s_barrier()
#define PG8_SCHED __builtin_amdgcn_sched_barrier(0)
    Unit cur, nxt; int ui = 0;
    if (!S.next(0, cur)) return;
    f32x4 acc[2][2][4][2];
#pragma unroll
    for (int a = 0; a < 2; ++a)
#pragma unroll
        for (int b = 0; b < 2; ++b)
#pragma unroll
            for (int m = 0; m < 4; ++m)
#pragma unroll
                for (int n = 0; n < 2; ++n) acc[a][b][m][n] = (f32x4){0.f, 0.f, 0.f, 0.f};
    bf16x8 At[4][2], B0[2][2], B1[2][2];
    const char* cA = (const char*)g.A + (size_t)cur.pm * tstep; const char* cB = (const char*)g.Bt + (size_t)cur.pn * tstep;
    S.a_ready(cur);
    if constexpr (SP2) {
        PG8_STAGE(PG8_SB(0, 0), cB, voffB); PG8_STAGE(PG8_SB(0, 1), cB + hstep, voffB); PG8_STAGE(PG8_SA(0, 0), cA, voffA); PG8_STAGE(PG8_SA(0, 1), cA + hstep, voffA);
        if (wr == 1) PG8_BAR;
        PG8_WAIT_V(2); PG8_BAR;
        PG8_STAGE(PG8_SB(1, 0), cB + kstep, voffB); PG8_STAGE(PG8_SA(1, 0), cA + kstep, voffA); PG8_STAGE(PG8_SB(1, 1), cB + hstep + kstep, voffB);
        PG8_WAIT_V(6); PG8_BAR;
    } else {
        PG8_STAGE(PG8_SB(0, 0), cB, voffB); PG8_STAGE(PG8_SA(0, 0), cA, voffA); PG8_STAGE(PG8_SB(0, 1), cB + hstep, voffB); PG8_STAGE(PG8_SA(0, 1), cA + hstep, voffA);
        if (wr == 1) PG8_BAR;
        PG8_WAIT_V(4); PG8_BAR;
        PG8_STAGE(PG8_SB(1, 0), cB + kstep, voffB); PG8_STAGE(PG8_SA(1, 0), cA + kstep, voffA); PG8_STAGE(PG8_SB(1, 1), cB + hstep + kstep, voffB);
        PG8_WAIT_V(6); PG8_BAR;
    }
    for (;;) {
        const bool has_next = S.next(ui + 1, nxt);
        const char* nA = has_next ? (const char*)g.A + (size_t)nxt.pm * tstep : cA; const char* nB = has_next ? (const char*)g.Bt + (size_t)nxt.pn * tstep : cB;
#pragma unroll 1
        for (int t = 0; t < nt; t += 2) {
            const bool last = (t == nt - 2);
            const char* a1 = cA + (size_t)(t + 1) * kstep;
            const char* a2 = last ? nA : cA + (size_t)(t + 2) * kstep; const char* b2 = last ? nB : cB + (size_t)(t + 2) * kstep;
            const char* a3 = a2 + kstep; const char* b3 = b2 + kstep;
            if (last && has_next) S.a_ready(nxt);
            if constexpr (SP2) {
            PG8_LDB(B0, 0, 0); PG8_LDB(B1, 0, 1); PG8_SCHED; PG8_LDA(At, 0, 0); PG8_STAGE(PG8_SA(1, 1), a1 + hstep, voffA);
            PG8_WAIT_V(8); PG8_WAIT_L(0); PG8_BAR; PG8_MMA(0, 0, At, B0); PG8_MMA(0, 1, At, B1); PG8_BAR; PG8_SCHED;
            PG8_LDA(At, 0, 1); PG8_STAGE(PG8_SB(0, 0), b2, voffB); PG8_STAGE(PG8_SB(0, 1), b2 + hstep, voffB); PG8_STAGE(PG8_SA(0, 0), a2, voffA);
            PG8_WAIT_V(8); PG8_WAIT_L(0); PG8_BAR; PG8_MMA(1, 0, At, B0); PG8_MMA(1, 1, At, B1); PG8_BAR; PG8_SCHED;
            PG8_LDB(B0, 1, 0); PG8_LDB(B1, 1, 1); PG8_SCHED; PG8_LDA(At, 1, 0); PG8_STAGE(PG8_SA(0, 1), a2 + hstep, voffA);
            PG8_WAIT_V(8); PG8_WAIT_L(0); PG8_BAR; PG8_MMA(0, 0, At, B0); PG8_MMA(0, 1, At, B1); PG8_BAR; PG8_SCHED;
            PG8_LDA(At, 1, 1); PG8_STAGE(PG8_SB(1, 0), b3, voffB); PG8_STAGE(PG8_SB(1, 1), b3 + hstep, voffB); PG8_STAGE(PG8_SA(1, 0), a3, voffA);
            PG8_WAIT_V(8); PG8_WAIT_L(0); PG8_BAR; PG8_MMA(1, 0, At, B0); PG8_MMA(1, 1, At, B1); PG8_BAR; PG8_SCHED;
            } else {
            PG8_LDB(B0, 0, 0); PG8_SCHED; PG8_LDA(At, 0, 0); PG8_STAGE(PG8_SA(1, 1), a1 + hstep, voffA);
            PG8_WAIT_L(8); PG8_BAR; PG8_WAIT_L(0); PG8_MMA(0, 0, At, B0); PG8_BAR; PG8_SCHED;
            PG8_LDB(B1, 0, 1); PG8_STAGE(PG8_SB(0, 0), b2, voffB);
            PG8_BAR; PG8_WAIT_L(0); PG8_MMA(0, 1, At, B1); PG8_BAR;
            PG8_LDA(At, 0, 1); PG8_STAGE(PG8_SA(0, 0), a2, voffA);
            PG8_BAR; PG8_WAIT_L(0); PG8_MMA(1, 0, At, B0); PG8_BAR; PG8_SCHED;
            PG8_STAGE(PG8_SB(0, 1), b2 + hstep, voffB);
            PG8_WAIT_V(6); PG8_BAR; PG8_MMA(1, 1, At, B1); PG8_BAR;
            PG8_LDB(B0, 1, 0); PG8_SCHED; PG8_LDA(At, 1, 0); PG8_STAGE(PG8_SA(0, 1), a2 + hstep, voffA);
            PG8_WAIT_L(8); PG8_BAR; PG8_WAIT_L(0); PG8_MMA(0, 0, At, B0); PG8_BAR; PG8_SCHED;
            PG8_LDB(B1, 1, 1); PG8_STAGE(PG8_SB(1, 0), b3, voffB);
            PG8_BAR; PG8_WAIT_L(0); PG8_MMA(0, 1, At, B1); PG8_BAR;
            PG8_LDA(At, 1, 1); PG8_STAGE(PG8_SA(1, 0), a3, voffA);
            PG8_BAR; PG8_WAIT_L(0); PG8_MMA(1, 0, At, B0); PG8_BAR; PG8_SCHED;
            PG8_STAGE(PG8_SB(1, 1), b3 + hstep, voffB);
            PG8_WAIT_V(6); PG8_BAR; PG8_MMA(1, 1, At, B1); PG8_BAR;
            }
        }
        if constexpr (ALIGN_EPI) { if (wr == 0) PG8_BAR; }
        if constexpr (!Epi::AFTER_DRAIN) { E(acc, cur, wr, wc, fr, fq); S.done(cur); }
        if (!has_next) break;
#pragma unroll
        for (int a = 0; a < 2; ++a)
#pragma unroll
            for (int b = 0; b < 2; ++b)
#pragma unroll
                for (int m = 0; m < 4; ++m)
#pragma unroll
                    for (int n = 0; n < 2; ++n) acc[a][b][m][n] = (f32x4){0.f, 0.f, 0.f, 0.f};
        cur = nxt; cA = nA; cB = nB; ++ui;
        if constexpr (ALIGN_EPI) { if (wr == 1) PG8_BAR; }
    }
    PG8_WAIT_V(0);
    if constexpr (!ALIGN_EPI) { if (wr == 0) PG8_BAR; }
    PG8_BAR;
    if constexpr (Epi::AFTER_DRAIN) { E.fused(acc, cur, wr, wc, fr, fq, lds, wid, lane); }
#undef PG8_SA
#undef PG8_SB
#undef PG8_STAGE
#undef PG8_LDA
#undef PG8_LDB
#undef PG8_MMA
#undef PG8_WAIT_V
#undef PG8_WAIT_L
#undef PG8_BAR
#undef PG8_SCHED
}
}

constexpr int DM = 1024, NCTX = 8192, NTOK = 16384, NKROW = 18432;
constexpr int IN_W = 2256, IN_WP = 2304, DFF = 2816;
constexpr float NORM_EPS = 1e-6f;
constexpr float QSCALE = 0.07216878364870322f * 1.4426950408889634f;

constexpr size_t MiB = 1u << 20;
constexpr size_t WS_MOD = 1 * MiB, WS_ROPE = 1 * MiB + 512 * 1024;
constexpr size_t WS_WIN = 2 * MiB, WS_WUQ = 6 * MiB + 512 * 1024, WS_WKN = 7 * MiB + 256 * 1024, WS_WV = 7 * MiB + 512 * 1024, WS_WOUT = 8 * MiB, WS_WGU = 10 * MiB, WS_WDN = 21 * MiB;
constexpr size_t WS_DTR = 27 * MiB, WS_DT = 28 * MiB;
constexpr size_t WS_H = 30 * MiB, WS_PA = 62 * MiB, WS_Z = 84 * MiB, WS_XBC = 100 * MiB, WS_QN = 132 * MiB, WS_CKV = 144 * MiB, WS_KR = 153 * MiB, WS_XS = 156 * MiB;
constexpr size_t WS_YF = 188 * MiB, WS_YB = 220 * MiB;
constexpr size_t WS_Q = 30 * MiB, WS_KN = 54 * MiB, WS_VT = 100 * MiB, WS_MIX = 118 * MiB, WS_OM = 150 * MiB, WS_ACT = 62 * MiB, WS_F = 150 * MiB;
constexpr size_t WS_Y1 = 150 * MiB;
constexpr int LDS_BYTES = 147456;

typedef float f32x2v_ __attribute__((ext_vector_type(2)));
typedef __bf16 bf16x2v_ __attribute__((ext_vector_type(2)));
DI unsigned pk2(float lo, float hi) { const f32x2v_ v = {lo, hi}; const bf16x2v_ b = __builtin_convertvector(v, bf16x2v_); return __builtin_bit_cast(unsigned, b); }
DI float bflo(unsigned u) { return __uint_as_float(u << 16); }
DI float bfhi(unsigned u) { return __uint_as_float(u & 0xffff0000u); }
DI float bf2f(unsigned short b) { return __uint_as_float((unsigned)b << 16); }
DI unsigned short f2bf1(float f) { return (unsigned short)(pk2(f, 0.f) & 0xffffu); }
DI float wave_sum(float v) {
#pragma unroll
    for (int o = 1; o < 64; o <<= 1) v += __shfl_xor(v, o);
    return v;
}
DI float silu_f(float v) { return v * __builtin_amdgcn_rcpf(1.f + __expf(-v)); }
DI int crow(int i, int h) { return (i & 3) + 8 * (i >> 2) + 4 * h; }
#define LDS_WAIT() asm volatile("s_waitcnt lgkmcnt(0)" ::: "memory")
#define MFMA32(a, b, c) __builtin_amdgcn_mfma_f32_32x32x16_bf16((a), (b), (c), 0, 0, 0)
#define MFMA16(a, b, c) __builtin_amdgcn_mfma_f32_16x16x32_bf16((a), (b), (c), 0, 0, 0)

template <class F> struct Epi8 {
    static constexpr bool PERM = true, AFTER_DRAIN = false;
    F f;
    DI void operator()(const f32x4 (&acc)[2][2][4][2], const pg8::Unit& u, int wr, int wc, int fr, int fq) const {
        const int row0 = u.pm * 256 + wr * 64 + fr, col0 = u.pn * 256 + wc * 32 + 8 * fq;
#pragma unroll
        for (int ai = 0; ai < 2; ++ai)
#pragma unroll
            for (int m = 0; m < 4; ++m)
#pragma unroll
                for (int bj = 0; bj < 2; ++bj) f(row0 + ai * 128 + m * 16, col0 + bj * 128, acc[ai][bj][m][0], acc[ai][bj][m][1]);
    }
};
DI void st8bf(bf16* p, f32x4 v0, f32x4 v1) { u32x4 w; w.x = pk2(v0[0], v0[1]); w.y = pk2(v0[2], v0[3]); w.z = pk2(v1[0], v1[1]); w.w = pk2(v1[2], v1[3]); *(u32x4*)p = w; }
DI void st8f(float* p, f32x4 v0, f32x4 v1) { *(f32x4*)p = v0; *(f32x4*)(p + 4) = v1; }

struct FInProj { bf16* PA; bf16* Z; bf16* XBC; float* DTR;
    DI void operator()(int row, int col, f32x4 v0, f32x4 v1) const {
        if (col < 704) st8bf(PA + (size_t)row * 704 + col, v0, v1);
        else if (col < 1216) st8bf(Z + (size_t)row * 512 + (col - 704), v0, v1);
        else if (col < 2240) st8bf(XBC + (size_t)row * 1024 + (col - 1216), v0, v1);
        else if (col < 2256) st8f(DTR + (size_t)row * 16 + (col - 2240), v0, v1);
    }
};
struct FQUp { bf16* Q;
    DI void operator()(int row, int col, f32x4 v0, f32x4 v1) const { st8bf(Q + (size_t)row * 768 + col, v0 * QSCALE, v1 * QSCALE); }
};
struct FBf { bf16* O; int ld; DI void operator()(int row, int col, f32x4 v0, f32x4 v1) const { st8bf(O + (size_t)row * ld + col, v0, v1); } };
struct FF32 { float* O; int ld; DI void operator()(int row, int col, f32x4 v0, f32x4 v1) const { st8f(O + (size_t)row * ld + col, v0, v1); } };
struct EpiGateUp {
    static constexpr bool PERM = true, AFTER_DRAIN = false;
    bf16* ACT;
    DI void operator()(const f32x4 (&acc)[2][2][4][2], const pg8::Unit& u, int wr, int wc, int fr, int fq) const {
        const int row0 = u.pm * 256 + wr * 64 + fr, f0 = u.pn * 128 + wc * 32 + 8 * fq;
#pragma unroll
        for (int ai = 0; ai < 2; ++ai)
#pragma unroll
            for (int m = 0; m < 4; ++m) { const f32x4 g0 = acc[ai][0][m][0], g1 = acc[ai][0][m][1], u0 = acc[ai][1][m][0], u1 = acc[ai][1][m][1];
                u32x4 w; w.x = pk2(silu_f(g0[0]) * u0[0], silu_f(g0[1]) * u0[1]); w.y = pk2(silu_f(g0[2]) * u0[2], silu_f(g0[3]) * u0[3]);
                w.z = pk2(silu_f(g1[0]) * u1[0], silu_f(g1[1]) * u1[1]); w.w = pk2(silu_f(g1[2]) * u1[2], silu_f(g1[3]) * u1[3]);
                *(u32x4*)(ACT + (size_t)(row0 + ai * 128 + m * 16) * DFF + f0) = w; }
    }
};

template <int MODE  >
DI void tr_item(const float* W, int K, int N, bf16* WT, LAS float* scr, int kb, int nb, int lane, int dst_row0) {
    const int k0 = 64 * kb, n0 = 32 * nb, nn = n0 + (lane & 31);
#pragma unroll
    for (int i = 0; i < 32; ++i) { const int kk = 2 * i + (lane >> 5); scr[kk * 33 + (lane & 31)] = (nn < N) ? __builtin_nontemporal_load(W + (size_t)(k0 + kk) * N + nn) : 0.f; }
    LDS_WAIT(); asm volatile("" ::: "memory");
    const int c = lane & 7;
#pragma unroll
    for (int j = 0; j < 4; ++j) { const int nl = (lane >> 3) + 8 * j; const LAS float* s = scr + (8 * c) * 33 + nl;
        u32x4 o; o.x = pk2(s[0 * 33], s[1 * 33]); o.y = pk2(s[2 * 33], s[3 * 33]); o.z = pk2(s[4 * 33], s[5 * 33]); o.w = pk2(s[6 * 33], s[7 * 33]);
        const int f = n0 + nl;
        const int row = (MODE == 0) ? (dst_row0 + nl) : ((f >> 7) * 256 + (MODE == 2 ? 128 : 0) + (f & 127));
        *(u32x4*)(WT + (size_t)row * K + k0 + 8 * c) = o; }
    LDS_WAIT(); asm volatile("" ::: "memory");
}

DI void phase0(LAS unsigned char* lds, const float* const* in, unsigned char* ws, int G) {
    const int tid = threadIdx.x, lane = tid & 63, wave = tid >> 6, bx = blockIdx.x;
    const float* c = in[5]; const float* c_ctx = in[6]; const float* w_mod = in[7]; const float* b_mod = in[8];
    float* mod = (float*)(ws + WS_MOD);
    if (bx < 192) {
        LAS float* sc = (LAS float*)lds;
        LAS float* red = (LAS float*)(lds + 36864);
        for (int i = tid; i < 9 * 1024; i += 512) { const int j = i >> 10, k = i & 1023; const float v = (j == 0) ? c_ctx[k] : c[(j - 1) * 1024 + k]; sc[i] = v / (1.f + expf(-v)); }
        __syncthreads();
        for (int item = bx; item < 192; item += G) {
            const int cc = tid & 31, kg = tid >> 5, col = item * 32 + cc;
            float a0 = 0.f, a1 = 0.f, a2 = 0.f, a3 = 0.f, a4 = 0.f, a5 = 0.f, a6 = 0.f, a7 = 0.f, a8 = 0.f;
#pragma unroll 16
            for (int i = 0; i < 64; ++i) { const int k = kg * 64 + i; const float w = __builtin_nontemporal_load(w_mod + (size_t)k * 6144 + col);
                a0 += sc[k] * w; a1 += sc[1024 + k] * w; a2 += sc[2048 + k] * w; a3 += sc[3072 + k] * w; a4 += sc[4096 + k] * w;
                a5 += sc[5120 + k] * w; a6 += sc[6144 + k] * w; a7 += sc[7168 + k] * w; a8 += sc[8192 + k] * w; }
            LAS float* rp = red + kg * 288 + cc;
            rp[0] = a0; rp[32] = a1; rp[64] = a2; rp[96] = a3; rp[128] = a4; rp[160] = a5; rp[192] = a6; rp[224] = a7; rp[256] = a8;
            __syncthreads();
            if (tid < 288) { const int j = tid >> 5, c2 = tid & 31; float s = b_mod[item * 32 + c2];
#pragma unroll
                for (int q = 0; q < 16; ++q) s += red[q * 288 + j * 32 + c2];
                mod[j * 6144 + item * 32 + c2] = s; }
            __syncthreads();
        }
    }
    if (bx == G - 1) {
        float* T = (float*)(ws + WS_ROPE);
        for (int e = tid; e < 1024; e += 512) { const int pos = e >> 4, i = e & 15;
            const float invf = exp2f(-(float)i * (13.287712379549449f / 16.f));
            const float ang = (float)pos * invf;
            const float n = rintf(ang * 0.15915494309189535f);
            float r = fmaf(-n, 6.28125f, ang); r = fmaf(-n, 1.9353071795864769e-3f, r);
            T[2 * e] = cosf(r); T[2 * e + 1] = sinf(r); }
    }
    __syncthreads();
    LAS float* scr = (LAS float*)(lds + 57344 + wave * 8704);
    const int gw = bx * 8 + wave, NGW = G * 8;
    constexpr int I_IN = 16 * 72, I_UQ = 6 * 24, I_KV = 4 * 32, I_OUT = 16 * 32;
    constexpr int NITEMS = I_IN + I_UQ + I_KV + I_OUT;
    for (int it = gw; it < NITEMS; it += NGW) {
        int r = it;
        if (r < I_IN) { const int kb = r / 72, nb = r % 72; tr_item<0>(in[11], 1024, IN_W, (bf16*)(ws + WS_WIN), scr, kb, nb, lane, 32 * nb); continue; } r -= I_IN;
        if (r < I_UQ) { const int kb = r / 24, nb = r % 24; tr_item<0>(in[13], 384, 768, (bf16*)(ws + WS_WUQ), scr, kb, nb, lane, 32 * nb); continue; } r -= I_UQ;
        if (r < I_KV) { const int kb = r / 32, nb = r % 32, c0 = 32 * nb, hh = c0 >> 8, e0 = c0 & 255;
            if (e0 < 128) tr_item<0>(in[15], 256, 1024, (bf16*)(ws + WS_WKN), scr, kb, nb, lane, hh * 128 + e0);
            else tr_item<0>(in[15], 256, 1024, (bf16*)(ws + WS_WV), scr, kb, nb, lane, hh * 128 + e0 - 128);
            continue; } r -= I_KV;
        { const int kb = r / 32, nb = r % 32; tr_item<0>(in[22], 1024, 1024, (bf16*)(ws + WS_WOUT), scr, kb, nb, lane, 32 * nb); }
    }
}
DI void ffn_weight_copies(LAS unsigned char* lds, const float* const* in, unsigned char* ws, int gw, int NGW) {
    const int lane = threadIdx.x & 63, wave = threadIdx.x >> 6;
    LAS float* scr = (LAS float*)(lds + 57344 + wave * 8704);
    constexpr int I_G = 16 * 88, I_DN = 44 * 32;
    for (int it = gw; it < 2 * I_G + I_DN; it += NGW) {
        int r = it;
        if (r < I_G) { const int kb = r / 88, nb = r % 88; tr_item<1>(in[25], 1024, DFF, (bf16*)(ws + WS_WGU), scr, kb, nb, lane, 0); continue; } r -= I_G;
        if (r < I_G) { const int kb = r / 88, nb = r % 88; tr_item<2>(in[26], 1024, DFF, (bf16*)(ws + WS_WGU), scr, kb, nb, lane, 0); continue; } r -= I_G;
        { const int kb = r / 32, nb = r % 32; tr_item<0>(in[27], DFF, 1024, (bf16*)(ws + WS_WDN), scr, kb, nb, lane, 32 * nb); }
    }
}

DI const float* xrow_ptr(const float* const* in, int r) { return (r < NCTX) ? in[0] + (size_t)r * DM : in[1] + (size_t)(r - NCTX) * DM; }
DI int mod_idx(int r) { return (r < NCTX) ? 0 : 1 + ((r - NCTX) >> 10); }

DI void phase1(const float* const* in, unsigned char* ws, int G) {
    const int lane = threadIdx.x & 63, wave = threadIdx.x >> 6, gw = blockIdx.x * 8 + wave, NGW = G * 8;
    const float* mod = (const float*)(ws + WS_MOD); const float* gp = in[9]; bf16* H = (bf16*)(ws + WS_H);
    f32x4 g[4];
#pragma unroll
    for (int j = 0; j < 4; ++j) g[j] = *(const f32x4*)(gp + 4 * lane + 256 * j);
    for (int r0 = gw; r0 < NTOK; r0 += 4 * NGW) {
        f32x4 v[4][4]; float s[4];
#pragma unroll
        for (int q = 0; q < 4; ++q) { const int r = r0 + q * NGW; const f32x4* xr = (const f32x4*)xrow_ptr(in, r < NTOK ? r : r0) + lane;
#pragma unroll
            for (int j = 0; j < 4; ++j) v[q][j] = __builtin_nontemporal_load(xr + 64 * j); }
#pragma unroll
        for (int q = 0; q < 4; ++q) { s[q] = 0.f;
#pragma unroll
            for (int j = 0; j < 4; ++j) s[q] += v[q][j].x * v[q][j].x + v[q][j].y * v[q][j].y + v[q][j].z * v[q][j].z + v[q][j].w * v[q][j].w; }
#pragma unroll
        for (int o = 1; o < 64; o <<= 1) {
#pragma unroll
            for (int q = 0; q < 4; ++q) s[q] += __shfl_xor(s[q], o); }
#pragma unroll
        for (int q = 0; q < 4; ++q) { const int r = r0 + q * NGW; if (r >= NTOK) break;
            const float rstd = rsqrtf(s[q] * (1.f / DM) + NORM_EPS); const float* mj = mod + mod_idx(r) * 6144;
            u32x2* o = (u32x2*)(H + (size_t)r * DM) + lane;
#pragma unroll
            for (int j = 0; j < 4; ++j) { const int k = 4 * lane + 256 * j;
                const f32x4 sc = *(const f32x4*)(mj + 1024 + k), sh = *(const f32x4*)(mj + k);
                const f32x4 h = v[q][j] * rstd * g[j] * (sc + 1.f) + sh;
                u32x2 w; w.x = pk2(h.x, h.y); w.y = pk2(h.z, h.w); o[64 * j] = w; } }
    }
}

struct P3Row { unsigned q0, q1, q2, k0, k1; unsigned short kr; u32x4 m1[2], c0[2], p1[2]; float dtr; };
DI void p3_load(P3Row& R, const bf16* PA, const bf16* XBC, const float* DTR, int r, int lane) {
    const bool ctx = r < NCTX; const int l = ctx ? (r & 255) : ((r - NCTX) & 1023), L = ctx ? 256 : 1024;
    const unsigned* pa = (const unsigned*)(PA + (size_t)r * 704);
    R.q0 = pa[lane]; R.q1 = pa[lane + 64]; R.q2 = pa[lane + 128]; R.k0 = pa[192 + lane]; R.k1 = pa[256 + lane];
    R.kr = PA[(size_t)r * 704 + 640 + lane];
    const u32x4 z4 = {0u, 0u, 0u, 0u};
#pragma unroll
    for (int jj = 0; jj < 2; ++jj) { const int ch = 8 * lane + 512 * jj;
        R.m1[jj] = (l > 0) ? *(const u32x4*)(XBC + (size_t)(r - 1) * 1024 + ch) : z4;
        R.c0[jj] = *(const u32x4*)(XBC + (size_t)r * 1024 + ch);
        R.p1[jj] = (l < L - 1) ? *(const u32x4*)(XBC + (size_t)(r + 1) * 1024 + ch) : z4; }
    R.dtr = DTR[(size_t)r * 16 + (lane & 15)];
}
DI void phase3(const float* const* in, float* out, unsigned char* ws, int G) {
    const int lane = threadIdx.x & 63, wave = threadIdx.x >> 6, gw = blockIdx.x * 8 + wave, NGW = G * 8;
    const bf16* PA = (const bf16*)(ws + WS_PA); const bf16* XBC = (const bf16*)(ws + WS_XBC);
    const float* DTR = (const float*)(ws + WS_DTR); float* DT = (float*)(ws + WS_DT);
    bf16* QN = (bf16*)(ws + WS_QN); bf16* CKV = (bf16*)(ws + WS_CKV); bf16* KR = (bf16*)(ws + WS_KR); bf16* XS = (bf16*)(ws + WS_XS);
    const float* rope = (const float*)(ws + WS_ROPE);
    const float* g_q = in[12]; const float* g_kv = in[14]; const float* conv_w = in[16]; const float* conv_b = in[17]; const float* dt_bias = in[18];
    float* out_ckv = out + 2 * (size_t)NCTX * DM; float* out_kr = out_ckv + (size_t)NCTX * 256;
    for (int rr = gw; rr < 2048; rr += NGW) {
        const int b = rr >> 8, j = rr & 255; const size_t krow = (size_t)NCTX + b * 1280 + j;
        const f32x4 v = __builtin_nontemporal_load((const f32x4*)(in[2] + (size_t)rr * 256) + lane);
        u32x2 w; w.x = pk2(v.x, v.y); w.y = pk2(v.z, v.w); *((u32x2*)(CKV + krow * 256) + lane) = w;
        KR[krow * 64 + lane] = f2bf1(in[3][(size_t)rr * 64 + lane]);
    }
    const float gq0 = g_q[2 * lane], gq1 = g_q[2 * lane + 1], gq2 = g_q[2 * lane + 128], gq3 = g_q[2 * lane + 129], gq4 = g_q[2 * lane + 256], gq5 = g_q[2 * lane + 257];
    const float gk0 = g_kv[2 * lane], gk1 = g_kv[2 * lane + 1], gk2 = g_kv[2 * lane + 128], gk3 = g_kv[2 * lane + 129];
    const float dtb = dt_bias[lane & 15];
    P3Row cur, nxt;
    if (gw < NTOK) p3_load(cur, PA, XBC, DTR, gw, lane);
    for (int r = gw; r < NTOK; r += NGW) {
        if (r + NGW < NTOK) p3_load(nxt, PA, XBC, DTR, r + NGW, lane);
        const bool ctx = r < NCTX;
        const int bl = ctx ? (r >> 8) : ((r - NCTX) >> 10), l = ctx ? (r & 255) : ((r - NCTX) & 1023);
        const size_t krow = ctx ? (size_t)r : (size_t)NCTX + bl * 1280 + 256 + l;
        { float a0 = bflo(cur.q0), a1 = bfhi(cur.q0), b0 = bflo(cur.q1), b1 = bfhi(cur.q1), c0 = bflo(cur.q2), c1 = bfhi(cur.q2);
          const float rstd = rsqrtf(wave_sum(a0 * a0 + a1 * a1 + b0 * b0 + b1 * b1 + c0 * c0 + c1 * c1) * (1.f / 384.f) + NORM_EPS);
          unsigned* q = (unsigned*)(QN + (size_t)r * 384);
          q[lane] = pk2(a0 * rstd * gq0, a1 * rstd * gq1); q[lane + 64] = pk2(b0 * rstd * gq2, b1 * rstd * gq3); q[lane + 128] = pk2(c0 * rstd * gq4, c1 * rstd * gq5); }
        { float a0 = bflo(cur.k0), a1 = bfhi(cur.k0), b0 = bflo(cur.k1), b1 = bfhi(cur.k1);
          const float rstd = rsqrtf(wave_sum(a0 * a0 + a1 * a1 + b0 * b0 + b1 * b1) * (1.f / 256.f) + NORM_EPS);
          a0 *= rstd * gk0; a1 *= rstd * gk1; b0 *= rstd * gk2; b1 *= rstd * gk3;
          unsigned* k = (unsigned*)(CKV + krow * 256); k[lane] = pk2(a0, a1); k[lane + 64] = pk2(b0, b1);
          if (ctx) { float* o = out_ckv + (size_t)r * 256; __builtin_nontemporal_store((f32x2_t){a0, a1}, (f32x2_t*)(o + 2 * lane)); __builtin_nontemporal_store((f32x2_t){b0, b1}, (f32x2_t*)(o + 2 * lane + 128)); } }
        { float v = bf2f(cur.kr);
          if (ctx) out_kr[(size_t)r * 64 + lane] = v;
          const float p = __shfl_xor(v, 16);
          if (!ctx) { const int pos = (lane < 32) ? (l >> 6) : (l & 63), idx = lane & 15; const float cs = rope[(pos * 16 + idx) * 2], sn = rope[(pos * 16 + idx) * 2 + 1];
              v = (lane & 16) ? (v * cs + p * sn) : (v * cs - p * sn); }
          KR[krow * 64 + lane] = f2bf1(v); }
#pragma unroll
        for (int jj = 0; jj < 2; ++jj) { const int ch = 8 * lane + 512 * jj;
            const f32x4 w0a = *(const f32x4*)(conv_w + ch), w0b = *(const f32x4*)(conv_w + ch + 4);
            const f32x4 w1a = *(const f32x4*)(conv_w + 1024 + ch), w1b = *(const f32x4*)(conv_w + 1024 + ch + 4);
            const f32x4 w2a = *(const f32x4*)(conv_w + 2048 + ch), w2b = *(const f32x4*)(conv_w + 2048 + ch + 4);
            const f32x4 ba = *(const f32x4*)(conv_b + ch), bb = *(const f32x4*)(conv_b + ch + 4);
            float y[8];
#pragma unroll
            for (int e = 0; e < 4; ++e) {
                const unsigned um = cur.m1[jj][e], uc = cur.c0[jj][e], up = cur.p1[jj][e];
                const float wlo0 = (e < 2) ? w0a[2 * e] : w0b[2 * e - 4], whi0 = (e < 2) ? w0a[2 * e + 1] : w0b[2 * e - 3];
                const float wlo1 = (e < 2) ? w1a[2 * e] : w1b[2 * e - 4], whi1 = (e < 2) ? w1a[2 * e + 1] : w1b[2 * e - 3];
                const float wlo2 = (e < 2) ? w2a[2 * e] : w2b[2 * e - 4], whi2 = (e < 2) ? w2a[2 * e + 1] : w2b[2 * e - 3];
                const float blo = (e < 2) ? ba[2 * e] : bb[2 * e - 4], bhi = (e < 2) ? ba[2 * e + 1] : bb[2 * e - 3];
                y[2 * e] = silu_f(blo + bflo(um) * wlo0 + bflo(uc) * wlo1 + bflo(up) * wlo2);
                y[2 * e + 1] = silu_f(bhi + bfhi(um) * whi0 + bfhi(uc) * whi1 + bfhi(up) * whi2);
            }
            u32x4 o; o.x = pk2(y[0], y[1]); o.y = pk2(y[2], y[3]); o.z = pk2(y[4], y[5]); o.w = pk2(y[6], y[7]);
            *(u32x4*)(XS + (size_t)r * 1024 + ch) = o; }
        if (lane < 16) { const float x = cur.dtr + dtb; DT[(size_t)r * 16 + lane] = fmaxf(x, 0.f) + log1pf(__expf(-fabsf(x))); }
        cur = nxt;
    }
}

struct P6Row { u32x4 yf, yb, xs, zz; };
DI void p6_load(P6Row& R, const bf16* YF, const bf16* YB, const bf16* XS, const bf16* Z, int r, int ch) {
    R.yf = *(const u32x4*)(YF + (size_t)r * 512 + ch); R.yb = *(const u32x4*)(YB + (size_t)r * 512 + ch);
    R.xs = *(const u32x4*)(XS + (size_t)r * 1024 + ch); R.zz = *(const u32x4*)(Z + (size_t)r * 512 + ch);
}
DI void phase6(const float* const* in, unsigned char* ws, int G) {
    const int lane = threadIdx.x & 63, wave = threadIdx.x >> 6, gw = blockIdx.x * 8 + wave, NGW = G * 8;
    const bf16* YF = (const bf16*)(ws + WS_YF); const bf16* YB = (const bf16*)(ws + WS_YB); const bf16* XS = (const bf16*)(ws + WS_XS); const bf16* Z = (const bf16*)(ws + WS_Z);
    bf16* MIX = (bf16*)(ws + WS_MIX); const float* d_skip = in[20]; const float* g_out = in[21];
    const int ch = 8 * lane; const float dsk = d_skip[lane >> 3];
    const f32x4 g0 = *(const f32x4*)(g_out + ch), g1 = *(const f32x4*)(g_out + ch + 4);
    P6Row cur, nxt;
    if (gw < NTOK) p6_load(cur, YF, YB, XS, Z, gw, ch);
    for (int r = gw; r < NTOK; r += NGW) {
        if (r + NGW < NTOK) p6_load(nxt, YF, YB, XS, Z, r + NGW, ch);
        float y[8]; float s = 0.f;
#pragma unroll
        for (int e = 0; e < 4; ++e) {
            const float ylo = bflo(cur.yf[e]) + bflo(cur.yb[e]) + dsk * bflo(cur.xs[e]);
            const float yhi = bfhi(cur.yf[e]) + bfhi(cur.yb[e]) + dsk * bfhi(cur.xs[e]);
            y[2 * e] = ylo * silu_f(bflo(cur.zz[e])); y[2 * e + 1] = yhi * silu_f(bfhi(cur.zz[e]));
            s += y[2 * e] * y[2 * e] + y[2 * e + 1] * y[2 * e + 1];
        }
        const float rstd = rsqrtf(wave_sum(s) * (1.f / 512.f) + NORM_EPS);
        u32x4 o; o.x = pk2(y[0] * rstd * g0[0], y[1] * rstd * g0[1]); o.y = pk2(y[2] * rstd * g0[2], y[3] * rstd * g0[3]);
        o.z = pk2(y[4] * rstd * g1[0], y[5] * rstd * g1[1]); o.w = pk2(y[6] * rstd * g1[2], y[7] * rstd * g1[3]);
        *(u32x4*)(MIX + (size_t)r * 1024 + 512 + ch) = o;
        cur = nxt;
    }
}

DI void phase8(const float* const* in, float* out, unsigned char* ws, int G) {
    const int lane = threadIdx.x & 63, wave = threadIdx.x >> 6, gw = blockIdx.x * 8 + wave, NGW = G * 8;
    const float* mod = (const float*)(ws + WS_MOD); const float* OM = (const float*)(ws + WS_OM); bf16* H = (bf16*)(ws + WS_H);
    const float* g_post = in[10]; const float* g_pre = in[23];
    for (int r = gw; r < NTOK; r += NGW) {
        const f32x4* xr = (const f32x4*)xrow_ptr(in, r) + lane; const f32x4* om = (const f32x4*)(OM + (size_t)r * DM) + lane; const float* mj = mod + mod_idx(r) * 6144;
        f32x4 v[4], y[4]; float s = 0.f;
#pragma unroll
        for (int j = 0; j < 4; ++j) { v[j] = om[64 * j]; s += v[j].x * v[j].x + v[j].y * v[j].y + v[j].z * v[j].z + v[j].w * v[j].w; }
        const float rstd = rsqrtf(wave_sum(s) * (1.f / DM) + NORM_EPS);
        float s2 = 0.f;
#pragma unroll
        for (int j = 0; j < 4; ++j) { const int k = 4 * lane + 256 * j;
            const f32x4 g = *(const f32x4*)(g_post + k), gt = *(const f32x4*)(mj + 2048 + k);
            y[j] = xr[64 * j] + gt * (v[j] * rstd * g);
            s2 += y[j].x * y[j].x + y[j].y * y[j].y + y[j].z * y[j].z + y[j].w * y[j].w;
            *((f32x4*)(out + (size_t)r * DM) + lane + 64 * j) = y[j]; }
        const float rstd2 = rsqrtf(wave_sum(s2) * (1.f / DM) + NORM_EPS);
        u32x2* o = (u32x2*)(H + (size_t)r * DM) + lane;
#pragma unroll
        for (int j = 0; j < 4; ++j) { const int k = 4 * lane + 256 * j;
            const f32x4 g = *(const f32x4*)(g_pre + k), sc = *(const f32x4*)(mj + 4096 + k), sh = *(const f32x4*)(mj + 3072 + k);
            const f32x4 h = y[j] * rstd2 * g * (sc + 1.f) + sh;
            u32x2 w; w.x = pk2(h.x, h.y); w.y = pk2(h.z, h.w); o[64 * j] = w; }
    }
}

DI void phase11(const float* const* in, float* out, unsigned char* ws, int G) {
    const int lane = threadIdx.x & 63, wave = threadIdx.x >> 6, gw = blockIdx.x * 8 + wave, NGW = G * 8;
    const float* mod = (const float*)(ws + WS_MOD); const float* F = (const float*)(ws + WS_F); const float* g_post = in[24];
    for (int r = gw; r < NTOK; r += NGW) {
        const f32x4* fr = (const f32x4*)(F + (size_t)r * DM) + lane; const float* mj = mod + mod_idx(r) * 6144;
        f32x4 v[4]; float s = 0.f;
#pragma unroll
        for (int j = 0; j < 4; ++j) { v[j] = fr[64 * j]; s += v[j].x * v[j].x + v[j].y * v[j].y + v[j].z * v[j].z + v[j].w * v[j].w; }
        const float rstd = rsqrtf(wave_sum(s) * (1.f / DM) + NORM_EPS);
#pragma unroll
        for (int j = 0; j < 4; ++j) { const int k = 4 * lane + 256 * j;
            const f32x4 g = *(const f32x4*)(g_post + k), gt = *(const f32x4*)(mj + 5120 + k);
            f32x4* o = (f32x4*)(out + (size_t)r * DM) + lane + 64 * j;
            *o = *o + gt * (v[j] * rstd * g); }
    }
}

constexpr int AK_STRIDE = 400, AV_STRIDE = 144, AV_OFF = 64 * AK_STRIDE, A_STAGE = AV_OFF + 128 * AV_STRIDE;
DI void attn_unit(LAS unsigned char* lds, const bf16* Q, const bf16* KN, const bf16* KR, const bf16* VT, bf16* MIX, const float* rope, int qrow0, int krow0, int nkt, int hh) {
    const int tid = threadIdx.x, lane = tid & 63, wave = tid >> 6, rg = wave & 3, kh = wave >> 2, r = lane & 31, hf = lane >> 5;
    bf16x8 qf[12];
    { const bf16* qp = Q + (size_t)(qrow0 + 32 * rg + r) * 768 + hh * 192 + 8 * hf;
#pragma unroll
      for (int ks = 0; ks < 12; ++ks) qf[ks] = *(const bf16x8*)(qp + 16 * ks); }
    if (rope) {
        const int l = (qrow0 + 32 * rg + r - NCTX) & 1023;
#pragma unroll
        for (int hfi = 0; hfi < 2; ++hfi) {
            const int pos = hfi ? (l & 63) : (l >> 6);
            const float* t = rope + (pos * 16 + 8 * hf) * 2;
            const u32x4 a = __builtin_bit_cast(u32x4, qf[8 + 2 * hfi]), b = __builtin_bit_cast(u32x4, qf[9 + 2 * hfi]); u32x4 ao, bo;
#pragma unroll
            for (int e = 0; e < 4; ++e) {
                const float x1l = bflo(a[e]), x1h = bfhi(a[e]), x2l = bflo(b[e]), x2h = bfhi(b[e]);
                const float c0 = t[4 * e], s0 = t[4 * e + 1], c1 = t[4 * e + 2], s1 = t[4 * e + 3];
                ao[e] = pk2(x1l * c0 - x2l * s0, x1h * c1 - x2h * s1);
                bo[e] = pk2(x2l * c0 + x1l * s0, x2h * c1 + x1h * s1);
            }
            qf[8 + 2 * hfi] = __builtin_bit_cast(bf16x8, ao); qf[9 + 2 * hfi] = __builtin_bit_cast(bf16x8, bo);
        }
    }
    f32x16 o[4];
#pragma unroll
    for (int d = 0; d < 4; ++d)
#pragma unroll
        for (int i = 0; i < 16; ++i) o[d][i] = 0.f;
    float mrun = -1e30f, lsum = 0.f;
    const int skey = tid >> 3, ssub = tid & 7, sd = tid >> 2, svs = tid & 3;
    const bf16* knp = KN + (size_t)(krow0 + skey) * 512 + hh * 128 + ssub * 8;
    const bf16* krp = KR + (size_t)(krow0 + skey) * 64 + ssub * 8;
    const bf16* vtp = VT + (size_t)(hh * 128 + sd) * NKROW + krow0 + svs * 8;
    const unsigned kdst0 = skey * AK_STRIDE + ssub * 16, vdst0 = AV_OFF + sd * AV_STRIDE + svs * 16;
    u32x4 pk[3], pv[2];
#define ATT_LOAD(kt_) do { const bf16* a_ = knp + (size_t)(kt_) * (64 * 512); pk[0] = *(const u32x4*)a_; pk[1] = *(const u32x4*)(a_ + 64); pk[2] = *(const u32x4*)(krp + (size_t)(kt_) * (64 * 64)); \
                           const bf16* v_ = vtp + (kt_) * 64; pv[0] = *(const u32x4*)v_; pv[1] = *(const u32x4*)(v_ + 32); } while (0)
#define ATT_WRITE(st_) do { LAS unsigned char* b_ = lds + (st_) * A_STAGE; *(LAS u32x4*)(b_ + kdst0) = pk[0]; *(LAS u32x4*)(b_ + kdst0 + 128) = pk[1]; *(LAS u32x4*)(b_ + kdst0 + 256) = pk[2]; \
                            *(LAS u32x4*)(b_ + vdst0) = pv[0]; *(LAS u32x4*)(b_ + vdst0 + 64) = pv[1]; } while (0)
    __syncthreads();
    ATT_LOAD(0); ATT_WRITE(0);
    if (nkt > 1) ATT_LOAD(1);
    __syncthreads();
    for (int kt = 0; kt < nkt; ++kt) {
        const int cur = kt & 1;
        if (kt + 1 < nkt) { ATT_WRITE(cur ^ 1); if (kt + 2 < nkt) ATT_LOAD(kt + 2); }
        const LAS unsigned char* stg = lds + cur * A_STAGE;
        f32x16 s;
#pragma unroll
        for (int i = 0; i < 16; ++i) s[i] = 0.f;
        {
            const LAS unsigned char* kp = stg + (32 * kh + r) * AK_STRIDE + 16 * hf;
            bf16x8 ka[4], kb[4];
#pragma unroll
            for (int i = 0; i < 4; ++i) ka[i] = *(const LAS bf16x8*)(kp + 32 * i);
#pragma unroll
            for (int i = 0; i < 4; ++i) kb[i] = *(const LAS bf16x8*)(kp + 32 * (4 + i));
            __builtin_amdgcn_sched_barrier(0);
#pragma unroll
            for (int i = 0; i < 4; ++i) s = MFMA32(ka[i], qf[i], s);
#pragma unroll
            for (int i = 0; i < 4; ++i) ka[i] = *(const LAS bf16x8*)(kp + 32 * (8 + i));
            __builtin_amdgcn_sched_barrier(0);
#pragma unroll
            for (int i = 0; i < 4; ++i) s = MFMA32(kb[i], qf[4 + i], s);
#pragma unroll
            for (int i = 0; i < 4; ++i) s = MFMA32(ka[i], qf[8 + i], s);
        }
        const LAS unsigned char* vbase = stg + AV_OFF + r * AV_STRIDE + (32 * kh + 4 * hf) * 2;
        s16x4 vlo[4], vhi[4];
#pragma unroll
        for (int d = 0; d < 4; ++d) { vlo[d] = *(const LAS s16x4*)(vbase + 32 * d * AV_STRIDE); vhi[d] = *(const LAS s16x4*)(vbase + 32 * d * AV_STRIDE + 16); }
        __builtin_amdgcn_sched_barrier(0);
        float mx = s[0];
#pragma unroll
        for (int i = 1; i < 16; ++i) mx = fmaxf(mx, s[i]);
        mx = fmaxf(mx, __shfl_xor(mx, 32));
        const float mnew = fmaxf(mrun, mx), alpha = __builtin_amdgcn_exp2f(mrun - mnew); mrun = mnew;
        float ps = 0.f;
#pragma unroll
        for (int i = 0; i < 16; ++i) { s[i] = __builtin_amdgcn_exp2f(s[i] - mnew); ps += s[i]; }
        lsum = lsum * alpha + ps;
#pragma unroll
        for (int d = 0; d < 4; ++d)
#pragma unroll
            for (int i = 0; i < 16; ++i) o[d][i] *= alpha;
        {
            u32x4 pw; pw.x = pk2(s[0], s[1]); pw.y = pk2(s[2], s[3]); pw.z = pk2(s[4], s[5]); pw.w = pk2(s[6], s[7]);
            const bf16x8 pf = __builtin_bit_cast(bf16x8, pw);
            bf16x8 vf[4];
#pragma unroll
            for (int d = 0; d < 4; ++d) vf[d] = __builtin_shufflevector(vlo[d], vhi[d], 0, 1, 2, 3, 4, 5, 6, 7);
#pragma unroll
            for (int d = 0; d < 4; ++d) { vlo[d] = *(const LAS s16x4*)(vbase + 32 * d * AV_STRIDE + 32); vhi[d] = *(const LAS s16x4*)(vbase + 32 * d * AV_STRIDE + 48); }
            __builtin_amdgcn_sched_barrier(0);
#pragma unroll
            for (int d = 0; d < 4; ++d) o[d] = MFMA32(vf[d], pf, o[d]);
        }
        {
            u32x4 pw; pw.x = pk2(s[8], s[9]); pw.y = pk2(s[10], s[11]); pw.z = pk2(s[12], s[13]); pw.w = pk2(s[14], s[15]);
            const bf16x8 pf = __builtin_bit_cast(bf16x8, pw);
#pragma unroll
            for (int d = 0; d < 4; ++d) { const bf16x8 vf = __builtin_shufflevector(vlo[d], vhi[d], 0, 1, 2, 3, 4, 5, 6, 7); o[d] = MFMA32(vf, pf, o[d]); }
        }
        __syncthreads();
    }
#undef ATT_LOAD
#undef ATT_WRITE
    lsum += __shfl_xor(lsum, 32);
    LAS float* Mg = (LAS float*)lds + rg * 4096; LAS float* ml = (LAS float*)(lds + 65536) + rg * 128;
    if (kh == 1) {
#pragma unroll
        for (int d = 0; d < 4; ++d)
#pragma unroll
            for (int i = 0; i < 16; ++i) Mg[(d * 16 + i) * 64 + lane] = o[d][i];
        ml[lane] = mrun; ml[64 + lane] = lsum;
    }
    __syncthreads();
    if (kh == 0) {
        const float m1 = ml[lane], l1 = ml[64 + lane], m = fmaxf(mrun, m1), a0 = __builtin_amdgcn_exp2f(mrun - m), a1 = __builtin_amdgcn_exp2f(m1 - m);
        const float inv = 1.f / (lsum * a0 + l1 * a1), w0 = a0 * inv, w1 = a1 * inv;
        bf16* op = MIX + (size_t)(qrow0 + 32 * rg + r) * 1024 + hh * 128 + 4 * hf;
#pragma unroll
        for (int d = 0; d < 4; ++d)
#pragma unroll
            for (int ig = 0; ig < 4; ++ig) { float v[4];
#pragma unroll
                for (int e = 0; e < 4; ++e) v[e] = o[d][4 * ig + e] * w0 + Mg[(d * 16 + 4 * ig + e) * 64 + lane] * w1;
                u32x2 w; w.x = pk2(v[0], v[1]); w.y = pk2(v[2], v[3]); *(u32x2*)(op + 32 * d + 8 * ig) = w; }
    }
}

constexpr int SS = 272;
constexpr int S_BS = 0, S_CS = 34816, S_BT = 69632, S_XT = 104448, S_SB = 121856, S_ACS = 139264, S_DT = 139776;
DI void ssd_item(LAS unsigned char* lds, const bf16* XS, const float* DT, const float* a_log, const float* st_in, float* st_out, bf16* Y, int row0, int L, int h, int dir) {
    const int tid = threadIdx.x, lane = tid & 63, wave = tid >> 6, r = lane & 31, hf = lane >> 5, pt = wave & 1, lt = (wave < 4) ? (wave >> 1) : (3 - ((wave - 4) >> 1));
    const int grp = h >> 2;
    const float a = -expf(a_log[dir * 8 + h]);
    LAS float* acs = (LAS float*)(lds + S_ACS); LAS float* dts = (LAS float*)(lds + S_DT);
    f32x16 S;
#pragma unroll
    for (int i = 0; i < 16; ++i) S[i] = st_in ? st_in[(size_t)(32 * pt + crow(i, hf)) * 128 + 32 * lt + r] : 0.f;
    const int nch = L >> 7;
    u32x4 vb[4], vc[4], vx[2]; float d0 = 0.f, d1 = 0.f;
    const int pcol = tid & 15, prow = tid >> 4, xcol = tid & 7, xrow = tid >> 3;
#define SSD_LOAD(ch_) do { \
        _Pragma("unroll") for (int k = 0; k < 4; ++k) { const int i0 = 128 * (ch_) + prow + 32 * k, t = dir ? (L - 1 - i0) : i0; \
            const bf16* rpb = XS + (size_t)(row0 + t) * 1024 + 512 + grp * 128 + 8 * pcol; vb[k] = *(const u32x4*)rpb; vc[k] = *(const u32x4*)(rpb + 256); } \
        _Pragma("unroll") for (int k = 0; k < 2; ++k) { const int i0 = 128 * (ch_) + xrow + 64 * k, t = dir ? (L - 1 - i0) : i0; \
            vx[k] = *(const u32x4*)(XS + (size_t)(row0 + t) * 1024 + h * 64 + 8 * xcol); } \
        if (wave == 0) { const int i0 = 128 * (ch_) + 2 * lane, t0 = dir ? (L - 1 - i0) : i0, t1 = dir ? (t0 - 1) : (t0 + 1); \
            d0 = DT[(size_t)(row0 + t0) * 16 + dir * 8 + h]; d1 = DT[(size_t)(row0 + t1) * 16 + dir * 8 + h]; } } while (0)
    for (int ch = 0; ch < nch; ++ch) {
        SSD_LOAD(ch);
        __syncthreads();
        if (wave == 0) {
            const float x0 = d0 * a, x1 = d1 * a; float v = x0 + x1;
#pragma unroll
            for (int o = 1; o < 64; o <<= 1) { const float n = __shfl_up(v, o); if (lane >= o) v += n; }
            acs[2 * lane] = v - x1; acs[2 * lane + 1] = v; dts[2 * lane] = d0; dts[2 * lane + 1] = d1;
        }
#pragma unroll
        for (int i = 0; i < 16; ++i) *(LAS unsigned short*)(lds + S_SB + (32 * pt + crow(i, hf)) * SS + (32 * lt + r) * 2) = f2bf1(S[i]);
        __syncthreads();
        const float acs_last = acs[127];
#pragma unroll
        for (int k = 0; k < 4; ++k) { const int l = prow + 32 * k;
            *(LAS u32x4*)(lds + S_BS + l * SS + pcol * 16) = vb[k]; *(LAS u32x4*)(lds + S_CS + l * SS + pcol * 16) = vc[k];
            const float wB = __expf(acs_last - acs[l]);
            LAS unsigned char* colb = lds + S_BT + (8 * pcol) * SS + ((((l >> 3) ^ pcol) << 3) + (l & 7)) * 2;
#pragma unroll
            for (int e = 0; e < 4; ++e) { const unsigned u = pk2(bflo(vb[k][e]) * wB, bfhi(vb[k][e]) * wB);
                *(LAS unsigned short*)(colb + (2 * e) * SS) = (unsigned short)(u & 0xffffu);
                *(LAS unsigned short*)(colb + (2 * e + 1) * SS) = (unsigned short)(u >> 16); } }
#pragma unroll
        for (int k = 0; k < 2; ++k) { const int l = xrow + 64 * k; const float wX = dts[l];
            LAS unsigned char* colb = lds + S_XT + (8 * xcol) * SS + ((((l >> 3) ^ xcol) << 3) + (l & 7)) * 2;
#pragma unroll
            for (int e = 0; e < 4; ++e) { const unsigned u = pk2(bflo(vx[k][e]) * wX, bfhi(vx[k][e]) * wX);
                *(LAS unsigned short*)(colb + (2 * e) * SS) = (unsigned short)(u & 0xffffu);
                *(LAS unsigned short*)(colb + (2 * e + 1) * SS) = (unsigned short)(u >> 16); } }
        __syncthreads();
        bf16x8 cf[8];
#pragma unroll
        for (int ks = 0; ks < 8; ++ks) cf[ks] = *(const LAS bf16x8*)(lds + S_CS + (32 * lt + r) * SS + (16 * ks + 8 * hf) * 2);
        const float acs_l = acs[32 * lt + r]; const int lcol = 32 * lt + r;
        const int cX = (4 * pt + (r >> 3)) & 7, cB = (4 * lt + (r >> 3)) & 15;
        f32x16 Yd;
#pragma unroll
        for (int i = 0; i < 16; ++i) Yd[i] = 0.f;
        for (int st = 0; st <= lt; ++st) {
            f32x16 cb;
#pragma unroll
            for (int i = 0; i < 16; ++i) cb[i] = 0.f;
            { bf16x8 bfr[8]; const LAS unsigned char* bp = lds + S_BS + (32 * st + r) * SS + 16 * hf;
#pragma unroll
              for (int ks = 0; ks < 8; ++ks) bfr[ks] = *(const LAS bf16x8*)(bp + 32 * ks);
              __builtin_amdgcn_sched_barrier(0);
#pragma unroll
              for (int ks = 0; ks < 8; ++ks) cb = MFMA32(bfr[ks], cf[ks], cb); }
            s16x4 xlo[2], xhi[2]; float av[16];
#pragma unroll
            for (int u = 0; u < 2; ++u) { const LAS unsigned char* xp = lds + S_XT + (32 * pt + r) * SS + 8 * hf; const int lg = 4 * st + 2 * u;
                xlo[u] = *(const LAS s16x4*)(xp + ((lg ^ cX) << 4)); xhi[u] = *(const LAS s16x4*)(xp + (((lg + 1) ^ cX) << 4)); }
#pragma unroll
            for (int i = 0; i < 16; ++i) av[i] = acs[32 * st + crow(i, hf)];
#pragma unroll
            for (int i = 0; i < 16; ++i) { const int sidx = 32 * st + crow(i, hf); const float e = __expf(acs_l - av[i]); cb[i] = (sidx <= lcol) ? cb[i] * e : 0.f; }
#pragma unroll
            for (int u = 0; u < 2; ++u) {
                u32x4 pw; pw.x = pk2(cb[8 * u], cb[8 * u + 1]); pw.y = pk2(cb[8 * u + 2], cb[8 * u + 3]); pw.z = pk2(cb[8 * u + 4], cb[8 * u + 5]); pw.w = pk2(cb[8 * u + 6], cb[8 * u + 7]);
                const bf16x8 pf = __builtin_bit_cast(bf16x8, pw);
                const bf16x8 xa = __builtin_shufflevector(xlo[u], xhi[u], 0, 1, 2, 3, 4, 5, 6, 7);
                Yd = MFMA32(xa, pf, Yd);
            }
        }
        f32x16 Yo;
#pragma unroll
        for (int i = 0; i < 16; ++i) Yo[i] = 0.f;
        { bf16x8 sa[8]; const LAS unsigned char* sp = lds + S_SB + (32 * pt + r) * SS + 16 * hf;
#pragma unroll
          for (int ks = 0; ks < 8; ++ks) sa[ks] = *(const LAS bf16x8*)(sp + 32 * ks);
          __builtin_amdgcn_sched_barrier(0);
#pragma unroll
          for (int ks = 0; ks < 8; ++ks) Yo = MFMA32(sa[ks], cf[ks], Yo); }
        { const float el = __expf(acs_l); const int i0 = 128 * ch + lcol, t = dir ? (L - 1 - i0) : i0;
          bf16* yp = Y + (size_t)(row0 + t) * 512 + h * 64 + 32 * pt + 4 * hf;
#pragma unroll
          for (int ig = 0; ig < 4; ++ig) { u32x2 v; v.x = pk2(Yd[4 * ig] + el * Yo[4 * ig], Yd[4 * ig + 1] + el * Yo[4 * ig + 1]); v.y = pk2(Yd[4 * ig + 2] + el * Yo[4 * ig + 2], Yd[4 * ig + 3] + el * Yo[4 * ig + 3]);
              *(u32x2*)(yp + 8 * ig) = v; } }
        { const float dl = __expf(acs_last);
#pragma unroll
          for (int i = 0; i < 16; ++i) S[i] *= dl;
          const LAS unsigned char* xp2 = lds + S_XT + (32 * pt + r) * SS; const LAS unsigned char* bp2 = lds + S_BT + (32 * lt + r) * SS;
#pragma unroll
          for (int half = 0; half < 2; ++half) { bf16x8 xa[4], bb[4];
#pragma unroll
              for (int k = 0; k < 4; ++k) { const int lg = 2 * (4 * half + k) + hf; xa[k] = *(const LAS bf16x8*)(xp2 + ((lg ^ cX) << 4)); bb[k] = *(const LAS bf16x8*)(bp2 + ((lg ^ cB) << 4)); }
              __builtin_amdgcn_sched_barrier(0);
#pragma unroll
              for (int k = 0; k < 4; ++k) S = MFMA32(xa[k], bb[k], S); } }
    }
#undef SSD_LOAD
    if (st_out) {
#pragma unroll
        for (int i = 0; i < 16; ++i) st_out[(size_t)(32 * pt + crow(i, hf)) * 128 + 32 * lt + r] = S[i];
    }
}

DI void phase5(LAS unsigned char* lds, const float* const* in, float* out, unsigned char* ws, int G) {
    const bf16* Q = (const bf16*)(ws + WS_Q); const bf16* KN = (const bf16*)(ws + WS_KN); const bf16* KR = (const bf16*)(ws + WS_KR); const bf16* VT = (const bf16*)(ws + WS_VT);
    bf16* MIX = (bf16*)(ws + WS_MIX);
    const int bxl = (int)blockIdx.x, vb = (G == 256) ? ((bxl & 7) * 32 + (bxl >> 3)) : bxl;
    for (int u = vb; u < 512; u += G) {
        if (u < 256) { const int b = u >> 5, hh = (u >> 3) & 3, qb = u & 7; attn_unit(lds, Q, KN, KR, VT, MIX, (const float*)(ws + WS_ROPE), NCTX + b * 1024 + qb * 128, NCTX + b * 1280, 20, hh); }
        else { const int v = u - 256, b = v >> 3, hh = (v >> 1) & 3, qb = v & 1; attn_unit(lds, Q, KN, KR, VT, MIX, nullptr, b * 256 + qb * 128, b * 256, 4, hh); }
    }
    const bf16* XS = (const bf16*)(ws + WS_XS); const float* DT = (const float*)(ws + WS_DT); const float* a_log = in[19];
    bf16* YF = (bf16*)(ws + WS_YF); bf16* YB = (bf16*)(ws + WS_YB);
    float* out_st = out + 2 * (size_t)NCTX * DM + (size_t)NCTX * 256 + (size_t)NCTX * 64;
    const int vs = (G == 256) ? (((bxl >> 3) < 16) ? ((bxl & 7) * 16 + (bxl >> 3)) : (128 + (bxl & 7) * 16 + (bxl >> 3) - 16)) : bxl;
    for (int s = vs; s < 256; s += G) {
        if (s < 128) { const int b = s >> 4, h = (s >> 1) & 7, dir = s & 1;
            ssd_item(lds, XS, DT, a_log, in[4] + ((size_t)(b * 2 + dir) * 8 + h) * 8192, nullptr, dir ? YB : YF, NCTX + b * 1024, 1024, h, dir); }
        else { for (int k = 0; k < 4; ++k) { const int it = (s - 128) * 4 + k, b = it >> 4, h = (it >> 1) & 7, dir = it & 1;
            ssd_item(lds, XS, DT, a_log, nullptr, out_st + ((size_t)(b * 2 + dir) * 8 + h) * 8192, dir ? YB : YF, b * 256, 256, h, dir); } }
    }
}

#define XB_TMO      128
#define XB_XCNT(j)  (256  + 64 * (j))
#define XB_XSUB(j)  (1280 + 64 * (j))
#define XB_XGEN(j)  (2304 + 64 * (j))
#define XB_TOP      3328
#define XB_TOPGEN   3392
#define XCD_BAR_WORDS 3456
#define XB_SPIN_CAP (1u << 18)
__device__ __forceinline__ unsigned xb_ld(unsigned* p)              { return __hip_atomic_load(p, __ATOMIC_RELAXED, __HIP_MEMORY_SCOPE_AGENT); }
__device__ __forceinline__ unsigned xb_add(unsigned* p, unsigned v) { return __hip_atomic_fetch_add(p, v, __ATOMIC_RELAXED, __HIP_MEMORY_SCOPE_AGENT); }
__device__ __forceinline__ unsigned xb_xcc_id() { return (unsigned)__builtin_amdgcn_s_getreg((3 << 11) | 20) & 0xFu; }
#define XB_SPIN(cond, bar) do { unsigned _sp = 0; while (cond) { __builtin_amdgcn_s_sleep(1); \
    if ((++_sp & 255u) == 0u) { if (xb_ld(&(bar)[XB_TMO])) break; if (_sp > XB_SPIN_CAP) { atomicAdd(&(bar)[XB_TMO], 1u); break; } } } } while (0)
struct XcdBarrier { unsigned* bar; unsigned x; volatile LAS unsigned* st; };
__device__ __forceinline__ XcdBarrier xcd_barrier_post(unsigned* bar, volatile LAS unsigned* st) {
    XcdBarrier b; b.bar = bar; b.x = xb_xcc_id(); b.st = st;
    if (threadIdx.x == 0) (void)xb_add(&bar[XB_XCNT(b.x)], 1u);
    return b;
}
__device__ __forceinline__ void xcd_barrier_complete(unsigned* bar, unsigned x, unsigned& nloc, unsigned& nx) {
    const unsigned G = gridDim.x * gridDim.y * gridDim.z;
    unsigned sum, cnt, mine, sp = 0u;
    for (;;) {
        sum = 0u; cnt = 0u; mine = 0u;
#pragma unroll
        for (unsigned j = 0; j < 16; ++j) { const unsigned c = xb_ld(&bar[XB_XCNT(j)]); sum += c; cnt += (c > 0u) ? 1u : 0u; mine = (j == x) ? c : mine; }
        if (sum == G) break;
        __builtin_amdgcn_s_sleep(1);
        if ((++sp & 255u) == 0u) { if (xb_ld(&bar[XB_TMO])) break; if (sp > XB_SPIN_CAP) { atomicAdd(&bar[XB_TMO], 1u); break; } }
    }
    nloc = mine > 0u ? mine : 1u; nx = cnt > 0u ? cnt : 1u;
}
__device__ __forceinline__ void xcd_barrier(const XcdBarrier& b) {
    asm volatile("s_waitcnt vmcnt(0)" ::: "memory");
    __syncthreads();
    if (threadIdx.x == 0) {
        unsigned* bar = b.bar;
        __builtin_amdgcn_s_waitcnt(0);
        unsigned nloc = b.st[0], nx = b.st[1];
        if (nloc == 0u) { xcd_barrier_complete(bar, b.x, nloc, nx); b.st[0] = nloc; b.st[1] = nx; }
        const unsigned old = xb_add(&bar[XB_XSUB(b.x)], 1u);
        const unsigned gen = old / nloc;
        if (old + 1u == (gen + 1u) * nloc) {
            __builtin_amdgcn_fence(__ATOMIC_RELEASE, "agent");
            asm volatile("s_waitcnt vmcnt(0)" ::: "memory");
            const unsigned og = xb_add(&bar[XB_TOP], 1u);
            const unsigned tg = og / nx;
            if (og + 1u == (tg + 1u) * nx) xb_add(&bar[XB_TOPGEN], 1u);
            else XB_SPIN(xb_ld(&bar[XB_TOPGEN]) == tg, bar);
            __builtin_amdgcn_fence(__ATOMIC_ACQUIRE, "agent");
            xb_add(&bar[XB_XGEN(b.x)], 1u);
            asm volatile("s_waitcnt vmcnt(0)" ::: "memory");
        } else {
            XB_SPIN(xb_ld(&bar[XB_XGEN(b.x)]) == gen, bar);
            __builtin_amdgcn_fence(__ATOMIC_ACQUIRE, "agent");
            asm volatile("s_waitcnt vmcnt(0)" ::: "memory");
        }
    }
    __syncthreads();
}
constexpr int LDS_BAR_OFF = 147392;
constexpr size_t CTL_ZERO_BYTES = 65536;

constexpr size_t WS_PS1 = 128 * 1024, WS_PS2 = 384 * 1024, WS_PS3 = 640 * 1024;
DI void panel_sumsq(const f32x4 (&acc)[2][2][4][2], LAS float* red, float* PS, const pg8::Unit& u, int wr, int wc, int fr, int fq) {
#pragma unroll
    for (int ai = 0; ai < 2; ++ai)
#pragma unroll
        for (int m = 0; m < 4; ++m) { float s = 0.f;
#pragma unroll
            for (int bj = 0; bj < 2; ++bj)
#pragma unroll
                for (int n = 0; n < 2; ++n)
#pragma unroll
                    for (int i = 0; i < 4; ++i) s += acc[ai][bj][m][n][i] * acc[ai][bj][m][n][i];
            s += __shfl_xor(s, 16); s += __shfl_xor(s, 32);
            if (fq == 0) red[wc * 256 + ai * 128 + wr * 64 + m * 16 + fr] = s; }
    __syncthreads();
    if (threadIdx.x < 256) { const int t = threadIdx.x; PS[u.pn * NTOK + u.pm * 256 + t] = red[t] + red[256 + t] + red[512 + t] + red[768 + t]; }
}
DI void panel_rstd(LAS float* rs, const float* PS, const pg8::Unit& u) {
    if (threadIdx.x < 256) { const int row = u.pm * 256 + threadIdx.x; rs[threadIdx.x] = rsqrtf((PS[row] + PS[NTOK + row] + PS[2 * NTOK + row] + PS[3 * NTOK + row]) * (1.f / DM) + NORM_EPS); }
    __syncthreads();
}
struct EpiMixFused {
    static constexpr bool PERM = true, AFTER_DRAIN = true;
    const float* x0; const float* x1; bf16* Y1; bf16* H; const float* mod; const float* g_post; const float* g_pre; float* PS1; float* PS2; XcdBarrier bar;
    DI void operator()(const f32x4 (&)[2][2][4][2], const pg8::Unit&, int, int, int, int) const {}
    DI void fused(f32x4 (&acc)[2][2][4][2], const pg8::Unit& u, int wr, int wc, int fr, int fq, LAS unsigned char* lds, int wid, int lane) const {
        LAS float* red = (LAS float*)lds; LAS float* rs = (LAS float*)(lds + 4096);
        const int row0 = u.pm * 256 + wr * 64 + fr, col0 = u.pn * 256 + wc * 32 + 8 * fq;
        const float* mj = mod + mod_idx(u.pm * 256) * 6144;
        panel_sumsq(acc, red, PS1, u, wr, wc, fr, fq);
        xcd_barrier(bar);
        panel_rstd(rs, PS1, u);
#pragma unroll
        for (int bj = 0; bj < 2; ++bj) { const int col = col0 + bj * 128;
            const f32x4 ca = *(const f32x4*)(mj + 2048 + col) * *(const f32x4*)(g_post + col), cb = *(const f32x4*)(mj + 2048 + col + 4) * *(const f32x4*)(g_post + col + 4);
#pragma unroll
            for (int ai = 0; ai < 2; ++ai)
#pragma unroll
                for (int m = 0; m < 4; ++m) { const int row = row0 + ai * 128 + m * 16; const float r = rs[ai * 128 + wr * 64 + m * 16 + fr];
                    const float* xr = ((row < NCTX) ? x0 + (size_t)row * DM : x1 + (size_t)(row - NCTX) * DM) + col;
                    const f32x4 y0 = __builtin_nontemporal_load((const f32x4*)xr) + ca * (acc[ai][bj][m][0] * r), y1 = __builtin_nontemporal_load((const f32x4*)(xr + 4)) + cb * (acc[ai][bj][m][1] * r);
                    acc[ai][bj][m][0] = y0; acc[ai][bj][m][1] = y1;
                    st8bf(Y1 + (size_t)row * DM + col, y0, y1); } }
        panel_sumsq(acc, red, PS2, u, wr, wc, fr, fq);
        xcd_barrier(bar);
        panel_rstd(rs, PS2, u);
#pragma unroll
        for (int bj = 0; bj < 2; ++bj) { const int col = col0 + bj * 128;
            const f32x4 ga = *(const f32x4*)(g_pre + col) * (*(const f32x4*)(mj + 4096 + col) + 1.f), gb = *(const f32x4*)(g_pre + col + 4) * (*(const f32x4*)(mj + 4096 + col + 4) + 1.f);
            const f32x4 sa = *(const f32x4*)(mj + 3072 + col), sb = *(const f32x4*)(mj + 3072 + col + 4);
#pragma unroll
            for (int ai = 0; ai < 2; ++ai)
#pragma unroll
                for (int m = 0; m < 4; ++m) { const int row = row0 + ai * 128 + m * 16; const float r = rs[ai * 128 + wr * 64 + m * 16 + fr];
                    st8bf(H + (size_t)row * DM + col, acc[ai][bj][m][0] * r * ga + sa, acc[ai][bj][m][1] * r * gb + sb); } }
    }
};
struct EpiFfnFused {
    static constexpr bool PERM = true, AFTER_DRAIN = true;
    float* out; const bf16* Y1; const float* mod; const float* g_post; float* PS; XcdBarrier bar;
    DI void operator()(const f32x4 (&)[2][2][4][2], const pg8::Unit&, int, int, int, int) const {}
    DI void fused(f32x4 (&acc)[2][2][4][2], const pg8::Unit& u, int wr, int wc, int fr, int fq, LAS unsigned char* lds, int wid, int lane) const {
        LAS float* red = (LAS float*)lds; LAS float* rs = (LAS float*)(lds + 4096);
        const int row0 = u.pm * 256 + wr * 64 + fr, col0 = u.pn * 256 + wc * 32 + 8 * fq;
        const float* mj = mod + mod_idx(u.pm * 256) * 6144;
        panel_sumsq(acc, red, PS, u, wr, wc, fr, fq);
        xcd_barrier(bar);
        panel_rstd(rs, PS, u);
#pragma unroll
        for (int bj = 0; bj < 2; ++bj) { const int col = col0 + bj * 128;
            const f32x4 ca = *(const f32x4*)(mj + 5120 + col) * *(const f32x4*)(g_post + col), cb = *(const f32x4*)(mj + 5120 + col + 4) * *(const f32x4*)(g_post + col + 4);
#pragma unroll
            for (int ai = 0; ai < 2; ++ai)
#pragma unroll
                for (int m = 0; m < 4; ++m) { const int row = row0 + ai * 128 + m * 16; const float r = rs[ai * 128 + wr * 64 + m * 16 + fr];
                    float* o = out + (size_t)row * DM + col; const u32x4 yv = *(const u32x4*)(Y1 + (size_t)row * DM + col);
                    const f32x4 ya = {bflo(yv.x), bfhi(yv.x), bflo(yv.y), bfhi(yv.y)}, yb = {bflo(yv.z), bfhi(yv.z), bflo(yv.w), bfhi(yv.w)};
                    __builtin_nontemporal_store(ya + ca * (acc[ai][bj][m][0] * r), (f32x4*)o); __builtin_nontemporal_store(yb + cb * (acc[ai][bj][m][1] * r), (f32x4*)(o + 4)); } }
    }
};

struct Args { const float* in[28]; float* out; unsigned char* ws; int ph_lo, ph_hi; };
constexpr int NPHASE = 12;

__global__ void __launch_bounds__(512, 2) mk_fwd(Args args) {
    extern __shared__ __attribute__((aligned(16))) unsigned char lds_raw[];
    LAS unsigned char* lds = (LAS unsigned char*)lds_raw;
    const int G = gridDim.x, bx = blockIdx.x;
    unsigned char* ws = args.ws; float* out = args.out; const float* const* in = args.in;
    const int lo = args.ph_lo, hi = args.ph_hi;
    if (lo < 0) cg::this_grid().sync();
    volatile LAS unsigned* bst = (volatile LAS unsigned*)(lds + LDS_BAR_OFF);
    if (threadIdx.x < 2) bst[threadIdx.x] = 0u;
    __syncthreads();
    XcdBarrier bar; bar.bar = (unsigned*)ws; bar.x = 0; bar.st = bst;
    if (hi - lo > 1) bar = xcd_barrier_post((unsigned*)ws, bst);
#ifndef P4SEL
#define P4SEL 7
#endif
#ifndef DUPMASK
#define DUPMASK 0
#endif
#define REP(k) for (int rep_ = 0; rep_ < 1 + ((DUPMASK >> (k)) & 1); ++rep_)
#ifndef PHMASK
#define PHMASK 0xfff
#endif
#define IN(k) (((PHMASK >> (k)) & 1) && lo <= (k) && (k) < hi)
#define SEAM(k) do { if (hi - lo > 1) { xcd_barrier(bar); } } while (0)
    typedef pg8::StaticOrder SO;
    if (IN(0)) REP(0) { phase0(lds, in, ws, G); __syncthreads(); }
    SEAM(0);
    if (IN(1)) REP(1) phase1(in, ws, G);
    SEAM(1);
    if (IN(2)) REP(2) {
        __syncthreads();
        pg8::Gemm g{(const bf16*)(ws + WS_H), (const bf16*)(ws + WS_WIN), NTOK, IN_WP, 1024}; SO S; S.init(NTOK, IN_WP, G, bx);
        Epi8<FInProj> E{{(bf16*)(ws + WS_PA), (bf16*)(ws + WS_Z), (bf16*)(ws + WS_XBC), (float*)(ws + WS_DTR)}};
        pg8::gemm_phase<Epi8<FInProj>, SO, true, true>(lds, g, S, E);
        if (G == 256) { if (bx >= 64) ffn_weight_copies(lds, in, ws, (bx - 64) * 8 + (int)(threadIdx.x >> 6), 192 * 8); }
        else ffn_weight_copies(lds, in, ws, bx * 8 + (int)(threadIdx.x >> 6), G * 8);
    }
    SEAM(2);
    if (IN(3)) REP(3) phase3(in, out, ws, G);
    SEAM(3);
    if (IN(4)) REP(4) {
        __syncthreads();
#if P4SEL & 1
        { pg8::Gemm g{(const bf16*)(ws + WS_QN), (const bf16*)(ws + WS_WUQ), NTOK, 768, 384}; SO S; S.init(NTOK, 768, G, bx);
          Epi8<FQUp> E{{(bf16*)(ws + WS_Q)}};
          pg8::gemm_phase<Epi8<FQUp>, SO, true, true>(lds, g, S, E); }
#endif
#if P4SEL & 2
        __syncthreads();
        { pg8::Gemm g{(const bf16*)(ws + WS_CKV), (const bf16*)(ws + WS_WKN), NKROW, 512, 256}; SO S; S.init(NKROW, 512, G, (bx + 64) % G);
          Epi8<FBf> E{{(bf16*)(ws + WS_KN), 512}};
          pg8::gemm_phase<Epi8<FBf>, SO, true, true>(lds, g, S, E); }
#endif
#if P4SEL & 4
        __syncthreads();
        { pg8::Gemm g{(const bf16*)(ws + WS_WV), (const bf16*)(ws + WS_CKV), 512, NKROW, 256}; SO S; S.init(512, NKROW, G, (bx + 176) % G);
          Epi8<FBf> E{{(bf16*)(ws + WS_VT), NKROW}};
          pg8::gemm_phase<Epi8<FBf>, SO, true, true>(lds, g, S, E); }
#endif
    }
    SEAM(4);
    if (IN(5)) phase5(lds, in, out, ws, G);
    SEAM(5);
    if (IN(6)) REP(6) phase6(in, ws, G);
    SEAM(6);
    if (IN(7)) {
        pg8::Gemm g{(const bf16*)(ws + WS_MIX), (const bf16*)(ws + WS_WOUT), NTOK, 1024, 1024}; SO S; S.init(NTOK, 1024, G, bx);
        EpiMixFused E{in[0], in[1], (bf16*)(ws + WS_Y1), (bf16*)(ws + WS_H), (const float*)(ws + WS_MOD), in[10], in[23], (float*)(ws + WS_PS1), (float*)(ws + WS_PS2), bar};
        pg8::gemm_phase<EpiMixFused, SO, false, true>(lds, g, S, E);
    }
    SEAM(7);
    if (IN(9)) REP(9) {
        __syncthreads();
        pg8::Gemm g{(const bf16*)(ws + WS_H), (const bf16*)(ws + WS_WGU), NTOK, 2 * DFF, 1024}; SO S; S.init(NTOK, 2 * DFF, G, bx);
        EpiGateUp E{(bf16*)(ws + WS_ACT)};
        pg8::gemm_phase<EpiGateUp, SO, true, true>(lds, g, S, E);
    }
    SEAM(9);
    if (IN(10)) {
        pg8::Gemm g{(const bf16*)(ws + WS_ACT), (const bf16*)(ws + WS_WDN), NTOK, 1024, DFF}; SO S; S.init(NTOK, 1024, G, bx);
        EpiFfnFused E{out, (const bf16*)(ws + WS_Y1), (const float*)(ws + WS_MOD), in[24], (float*)(ws + WS_PS3), bar};
        pg8::gemm_phase<EpiFfnFused, SO, false, true>(lds, g, S, E);
    }
#undef IN
#undef SEAM
}

extern "C" void kernel_launch(void* const* d_in, const int* in_sizes, int n_in, void* d_out, int out_size, void* d_ws, size_t ws_size, hipStream_t stream) {
    static int grid = 0;
    if (grid == 0) {
        int dev = 0, cus = 0, per_cu = 0;
        if (hipGetDevice(&dev) != hipSuccess || hipDeviceGetAttribute(&cus, hipDeviceAttributeMultiprocessorCount, dev) != hipSuccess) { fprintf(stderr, "kernel_launch: device query failed\n"); grid = -1; return; }
        if (hipFuncSetAttribute((const void*)mk_fwd, hipFuncAttributeMaxDynamicSharedMemorySize, LDS_BYTES) != hipSuccess) { fprintf(stderr, "kernel_launch: hipFuncSetAttribute failed\n"); grid = -1; return; }
        if (hipOccupancyMaxActiveBlocksPerMultiprocessor(&per_cu, (const void*)mk_fwd, 512, LDS_BYTES) != hipSuccess || per_cu < 1) { fprintf(stderr, "kernel_launch: occupancy query says %d blocks/CU\n", per_cu); grid = -1; return; }
        grid = cus;
        if (cus != 256) { fprintf(stderr, "kernel_launch: built for a 256-CU device (one 256x256 GEMM unit per workgroup in the fused-norm phases), got %d CUs\n", cus); grid = -1; return; }
        if (n_in != 28 || ws_size < 252 * MiB) { fprintf(stderr, "kernel_launch: unexpected n_in %d / ws %zu\n", n_in, ws_size); grid = -1; return; }
    }
    if (grid < 0) return;
    if (hipMemsetAsync(d_ws, 0, CTL_ZERO_BYTES, stream) != hipSuccess) { fprintf(stderr, "kernel_launch: memset failed\n"); return; }
    Args a{};
    for (int i = 0; i < 28; ++i) a.in[i] = (const float*)d_in[i];
    a.out = (float*)d_out; a.ws = (unsigned char*)d_ws;
    void* kargs[] = {&a};
#ifndef PROBE_HI
#define PROBE_HI 0
#endif
#if PROBE_HI > 0
    a.ph_lo = 0; a.ph_hi = PROBE_HI;
    (void)hipLaunchCooperativeKernel((const void*)mk_fwd, dim3(grid), dim3(512), kargs, LDS_BYTES, stream);
    (void)hipMemsetAsync(d_ws, 0, CTL_ZERO_BYTES, stream);
#endif
    a.ph_lo = 0; a.ph_hi = NPHASE;
    hipError_t e = hipLaunchCooperativeKernel((const void*)mk_fwd, dim3(grid), dim3(512), kargs, LDS_BYTES, stream);
    if (e != hipSuccess) fprintf(stderr, "kernel_launch: cooperative launch failed: %s (grid %d)\n", hipGetErrorString(e), grid);
}
```

```cpp
#include <hip/hip_runtime.h>
#include <cstdio>
#include <cstdint>

#ifndef MK_SPLIT
#define MK_SPLIT 0
#endif

#define DI __device__ __forceinline__
#define LAS __attribute__((address_space(3)))
typedef unsigned short bf16;
typedef float f32x4 __attribute__((ext_vector_type(4)));
typedef float f32x16 __attribute__((ext_vector_type(16)));
typedef short bf16x8 __attribute__((ext_vector_type(8)));
typedef short s16x4 __attribute__((ext_vector_type(4)));
typedef unsigned u32x4 __attribute__((ext_vector_type(4)));
typedef unsigned u32x2 __attribute__((ext_vector_type(2)));
typedef float f32x2_t __attribute__((ext_vector_type(2)));

namespace pg8 {
#define PG8_LAS __attribute__((address_space(3)))
typedef unsigned short bf16_t;
typedef short bf16x8 __attribute__((ext_vector_type(8)));
typedef float f32x4 __attribute__((ext_vector_type(4)));
typedef unsigned u32x4 __attribute__((ext_vector_type(4)));
constexpr int BM = 256, BK = 64, HALF = 128, HTB = HALF * BK * 2, STAGE_BYTES = 8 * HTB, NXCD = 8, WGM = 8;

__host__ __device__ __forceinline__ int lds_byte(int r, int c) { const int st = (r >> 4) * 2 + (c >> 5), rr = r & 15, cc = c & 31, ob = rr * 64 + cc * 2; return st * 1024 + (ob ^ (((ob >> 9) & 1) << 5)); }
__host__ __device__ __forceinline__ void stage_rc(int b, int& R, int& C) { const int st = b / 1024, sb = b % 1024, swz = sb ^ (((sb >> 9) & 1) << 5); R = (st >> 1) * 16 + swz / 64; C = (st & 1) * 32 + (swz % 64) / 2; }
__host__ __device__ __forceinline__ int perm32(int rho) { const int n = rho >> 4, i = rho & 15; return 8 * (i >> 2) + 4 * n + (i & 3); }

struct Unit { int pm, pn; };
struct Gemm { const bf16_t* A; const bf16_t* Bt; int M, N, K; };

struct StaticOrder {
    int nM, nN, nwg, G, c;
    __host__ __device__ void init(int M, int N, int G_, int c_) { nM = M / BM; nN = N / BM; nwg = nM * nN; G = G_; c = c_; }
    __host__ __device__ bool next(int i, Unit& u) const {
        const long L = (long)i * G + c; if (L >= nwg) return false;
        int wgid = (int)L; { const int q = nwg / NXCD, r = nwg % NXCD, xcd = wgid % NXCD, off = wgid / NXCD; wgid = (xcd < r ? xcd * (q + 1) : r * (q + 1) + (xcd - r) * q) + off; }
        const int nig = WGM * nN, gid = wgid / nig, fm = gid * WGM, gsz = (nM - fm) < WGM ? (nM - fm) : WGM;
        u.pm = fm + ((wgid % nig) % gsz); u.pn = (wgid % nig) / gsz; return true;
    }
    __device__ __forceinline__ void a_ready(const Unit&) const {}
    __device__ __forceinline__ void done(const Unit&) const {}
};

template <class Epi, class Sched, bool ALIGN_EPI = false, bool SP2 = false>
__device__ __forceinline__ void gemm_phase(PG8_LAS unsigned char* lds, const Gemm g, const Sched& S, const Epi& E) {
    const int tid = threadIdx.x, wid = __builtin_amdgcn_readfirstlane(tid >> 6), lane = tid & 63, wr = wid >> 2, wc = wid & 3, fr = lane & 15, fq = lane >> 4;
    int Kop = g.K; asm volatile("" : "+s"(Kop));
    const int K = Kop, nt = K / BK;
    unsigned voffA[2], voffB[2];
#pragma unroll
    for (int i = 0; i < 2; ++i) { int R, C; stage_rc(tid * 16 + i * 8192, R, C); const int Rb = Epi::PERM ? ((R & ~31) + perm32(R & 31)) : R;
        voffA[i] = (unsigned)(R * K + C) * 2u; voffB[i] = (unsigned)(Rb * K + C) * 2u; }
    const size_t kstep = (size_t)(BK * 2);
    const size_t hstep = (size_t)HALF * K * 2;
    const size_t tstep = 2 * hstep;
    const unsigned ldsw = (unsigned)wid * 1024u;
    const int aoff = lds_byte(wr * 64 + fr, fq * 8), boff = lds_byte(wc * 32 + fr, fq * 8);
#define PG8_SA(b, h) (((b) * 2 + (h)) * HTB)
#define PG8_SB(b, h) ((4 + (b) * 2 + (h)) * HTB)
#define PG8_STAGE(bufoff, gbase, voff) do { _Pragma("unroll") for (int _i = 0; _i < 2; ++_i) \
        __builtin_amdgcn_global_load_lds((const unsigned*)((const char*)(gbase) + (voff)[_i]), (PG8_LAS unsigned*)(lds + (bufoff) + ldsw + _i * 8192), 16, 0, 0); } while (0)
#define PG8_LDA(dst, b, h) do { _Pragma("unroll") for (int m = 0; m < 4; ++m) _Pragma("unroll") for (int k = 0; k < 2; ++k) dst[m][k] = *(const PG8_LAS bf16x8*)(lds + PG8_SA(b, h) + aoff + m * 2048 + k * 1024); } while (0)
#define PG8_LDB(dst, b, h) do { _Pragma("unroll") for (int n = 0; n < 2; ++n) _Pragma("unroll") for (int k = 0; k < 2; ++k) dst[n][k] = *(const PG8_LAS bf16x8*)(lds + PG8_SB(b, h) + boff + n * 2048 + k * 1024); } while (0)
#define PG8_MMA(ai, bj, At, Bt) do { __builtin_amdgcn_s_setprio(1); _Pragma("unroll") for (int m = 0; m < 4; ++m) _Pragma("unroll") for (int n = 0; n < 2; ++n) _Pragma("unroll") for (int k = 0; k < 2; ++k) \
        acc[ai][bj][m][n] = __builtin_amdgcn_mfma_f32_16x16x32_bf16(Bt[n][k], At[m][k], acc[ai][bj][m][n], 0, 0, 0); __builtin_amdgcn_s_setprio(0); } while (0)
#define PG8_WAIT_V(n) asm volatile("s_waitcnt vmcnt(" #n ")" ::: "memory")
#define PG8_WAIT_L(n) asm volatile("s_waitcnt lgkmcnt(" #n ")" ::: "memory")
#define PG8_BAR __builtin_amdgcn_s_barrier()
#define PG8_SCHED __builtin_amdgcn_sched_barrier(0)
    Unit cur, nxt; int ui = 0;
    if (!S.next(0, cur)) return;
    f32x4 acc[2][2][4][2];
#pragma unroll
    for (int a = 0; a < 2; ++a)
#pragma unroll
        for (int b = 0; b < 2; ++b)
#pragma unroll
            for (int m = 0; m < 4; ++m)
#pragma unroll
                for (int n = 0; n < 2; ++n) acc[a][b][m][n] = (f32x4){0.f, 0.f, 0.f, 0.f};
    bf16x8 At[4][2], B0[2][2], B1[2][2];
    const char* cA = (const char*)g.A + (size_t)cur.pm * tstep; const char* cB = (const char*)g.Bt + (size_t)cur.pn * tstep;
    S.a_ready(cur);
    if constexpr (SP2) {
        PG8_STAGE(PG8_SB(0, 0), cB, voffB); PG8_STAGE(PG8_SB(0, 1), cB + hstep, voffB); PG8_STAGE(PG8_SA(0, 0), cA, voffA); PG8_STAGE(PG8_SA(0, 1), cA + hstep, voffA);
        if (wr == 1) PG8_BAR;
        PG8_WAIT_V(2); PG8_BAR;
        PG8_STAGE(PG8_SB(1, 0), cB + kstep, voffB); PG8_STAGE(PG8_SA(1, 0), cA + kstep, voffA); PG8_STAGE(PG8_SB(1, 1), cB + hstep + kstep, voffB);
        PG8_WAIT_V(6); PG8_BAR;
    } else {
        PG8_STAGE(PG8_SB(0, 0), cB, voffB); PG8_STAGE(PG8_SA(0, 0), cA, voffA); PG8_STAGE(PG8_SB(0, 1), cB + hstep, voffB); PG8_STAGE(PG8_SA(0, 1), cA + hstep, voffA);
        if (wr == 1) PG8_BAR;
        PG8_WAIT_V(4); PG8_BAR;
        PG8_STAGE(PG8_SB(1, 0), cB + kstep, voffB); PG8_STAGE(PG8_SA(1, 0), cA + kstep, voffA); PG8_STAGE(PG8_SB(1, 1), cB + hstep + kstep, voffB);
        PG8_WAIT_V(6); PG8_BAR;
    }
    for (;;) {
        const bool has_next = S.next(ui + 1, nxt);
        const char* nA = has_next ? (const char*)g.A + (size_t)nxt.pm * tstep : cA; const char* nB = has_next ? (const char*)g.Bt + (size_t)nxt.pn * tstep : cB;
#pragma unroll 1
        for (int t = 0; t < nt; t += 2) {
            const bool last = (t == nt - 2);
            const char* a1 = cA + (size_t)(t + 1) * kstep;
            const char* a2 = last ? nA : cA + (size_t)(t + 2) * kstep; const char* b2 = last ? nB : cB + (size_t)(t + 2) * kstep;
            const char* a3 = a2 + kstep; const char* b3 = b2 + kstep;
            if (last && has_next) S.a_ready(nxt);
            if constexpr (SP2) {
            PG8_LDB(B0, 0, 0); PG8_LDB(B1, 0, 1); PG8_SCHED; PG8_LDA(At, 0, 0); PG8_STAGE(PG8_SA(1, 1), a1 + hstep, voffA);
            PG8_WAIT_V(8); PG8_WAIT_L(0); PG8_BAR; PG8_MMA(0, 0, At, B0); PG8_MMA(0, 1, At, B1); PG8_BAR; PG8_SCHED;
            PG8_LDA(At, 0, 1); PG8_STAGE(PG8_SB(0, 0), b2, voffB); PG8_STAGE(PG8_SB(0, 1), b2 + hstep, voffB); PG8_STAGE(PG8_SA(0, 0), a2, voffA);
            PG8_WAIT_V(8); PG8_WAIT_L(0); PG8_BAR; PG8_MMA(1, 0, At, B0); PG8_MMA(1, 1, At, B1); PG8_BAR; PG8_SCHED;
            PG8_LDB(B0, 1, 0); PG8_LDB(B1, 1, 1); PG8_SCHED; PG8_LDA(At, 1, 0); PG8_STAGE(PG8_SA(0, 1), a2 + hstep, voffA);
            PG8_WAIT_V(8); PG8_WAIT_L(0); PG8_BAR; PG8_MMA(0, 0, At, B0); PG8_MMA(0, 1, At, B1); PG8_BAR; PG8_SCHED;
            PG8_LDA(At, 1, 1); PG8_STAGE(PG8_SB(1, 0), b3, voffB); PG8_STAGE(PG8_SB(1, 1), b3 + hstep, voffB); PG8_STAGE(PG8_SA(1, 0), a3, voffA);
            PG8_WAIT_V(8); PG8_WAIT_L(0); PG8_BAR; PG8_MMA(1, 0, At, B0); PG8_MMA(1, 1, At, B1); PG8_BAR; PG8_SCHED;
            } else {
            PG8_LDB(B0, 0, 0); PG8_SCHED; PG8_LDA(At, 0, 0); PG8_STAGE(PG8_SA(1, 1), a1 + hstep, voffA);
            PG8_WAIT_L(8); PG8_BAR; PG8_WAIT_L(0); PG8_MMA(0, 0, At, B0); PG8_BAR; PG8_SCHED;
            PG8_LDB(B1, 0, 1); PG8_STAGE(PG8_SB(0, 0), b2, voffB);
            PG8_BAR; PG8_WAIT_L(0); PG8_MMA(0, 1, At, B1); PG8_BAR;
            PG8_LDA(At, 0, 1); PG8_STAGE(PG8_SA(0, 0), a2, voffA);
            PG8_BAR; PG8_WAIT_L(0); PG8_MMA(1, 0, At, B0); PG8_BAR; PG8_SCHED;
            PG8_STAGE(PG8_SB(0, 1), b2 + hstep, voffB);
            PG8_WAIT_V(6); PG8_BAR; PG8_MMA(1, 1, At, B1); PG8_BAR;
            PG8_LDB(B0, 1, 0); PG8_SCHED; PG8_LDA(At, 1, 0); PG8_STAGE(PG8_SA(0, 1), a2 + hstep, voffA);
            PG8_WAIT_L(8); PG8_BAR; PG8_WAIT_L(0); PG8_MMA(0, 0, At, B0); PG8_BAR; PG8_SCHED;
            PG8_LDB(B1, 1, 1); PG8_STAGE(PG8_SB(1, 0), b3, voffB);
            PG8_BAR; PG8_WAIT_L(0); PG8_MMA(0, 1, At, B1); PG8_BAR;
            PG8_LDA(At, 1, 1); PG8_STAGE(PG8_SA(1, 0), a3, voffA);
            PG8_BAR; PG8_WAIT_L(0); PG8_MMA(1, 0, At, B0); PG8_BAR; PG8_SCHED;
            PG8_STAGE(PG8_SB(1, 1), b3 + hstep, voffB);
            PG8_WAIT_V(6); PG8_BAR; PG8_MMA(1, 1, At, B1); PG8_BAR;
            }
        }
        if constexpr (ALIGN_EPI) { if (wr == 0) PG8_BAR; }
        if constexpr (!Epi::AFTER_DRAIN) { E(acc, cur, wr, wc, fr, fq); S.done(cur); }
        if (!has_next) break;
#pragma unroll
        for (int a = 0; a < 2; ++a)
#pragma unroll
            for (int b = 0; b < 2; ++b)
#pragma unroll
                for (int m = 0; m < 4; ++m)
#pragma unroll
                    for (int n = 0; n < 2; ++n) acc[a][b][m][n] = (f32x4){0.f, 0.f, 0.f, 0.f};
        cur = nxt; cA = nA; cB = nB; ++ui;
        if constexpr (ALIGN_EPI) { if (wr == 1) PG8_BAR; }
    }
    PG8_WAIT_V(0);
    if constexpr (!ALIGN_EPI) { if (wr == 0) PG8_BAR; }
    PG8_BAR;
    if constexpr (Epi::AFTER_DRAIN) { E.fused(acc, cur, wr, wc, fr, fq, lds, wid, lane); }
#undef PG8_SA
#undef PG8_SB
#undef PG8_STAGE
#undef PG8_LDA
#undef PG8_LDB
#undef PG8_MMA
#undef PG8_WAIT_V
#undef PG8_WAIT_L
#undef PG8_BAR
#undef PG8_SCHED
}
}

constexpr int DM = 1024, NCTX = 8192, NTOK = 16384, NKROW = 18432;
constexpr int IN_W = 2256, IN_WP = 2304, DFF = 2816;
constexpr float NORM_EPS = 1e-6f;
constexpr float QSCALE = 0.07216878364870322f * 1.4426950408889634f;

constexpr size_t MiB = 1u << 20;
constexpr size_t WS_MOD = 1 * MiB, WS_ROPE = 1 * MiB + 512 * 1024;
constexpr size_t WS_WIN = 2 * MiB, WS_WUQ = 6 * MiB + 512 * 1024, WS_WKN = 7 * MiB + 256 * 1024, WS_WV = 7 * MiB + 512 * 1024, WS_WOUT = 8 * MiB, WS_WGU = 10 * MiB, WS_WDN = 21 * MiB;
constexpr size_t WS_DTR = 27 * MiB, WS_DT = 28 * MiB;
constexpr size_t WS_H = 30 * MiB, WS_PA = 62 * MiB, WS_Z = 84 * MiB, WS_XBC = 100 * MiB, WS_QN = 132 * MiB, WS_CKV = 144 * MiB, WS_KR = 153 * MiB, WS_XS = 156 * MiB;
constexpr size_t WS_YF = 188 * MiB, WS_YB = 220 * MiB;
constexpr size_t WS_Q = 30 * MiB, WS_KN = 54 * MiB, WS_VT = 100 * MiB, WS_MIX = 118 * MiB, WS_OM = 150 * MiB, WS_ACT = 62 * MiB, WS_F = 150 * MiB;
constexpr size_t WS_Y1 = 150 * MiB;
constexpr int LDS_BYTES = 147456;

typedef float f32x2v_ __attribute__((ext_vector_type(2)));
typedef __bf16 bf16x2v_ __attribute__((ext_vector_type(2)));
DI unsigned pk2(float lo, float hi) { const f32x2v_ v = {lo, hi}; const bf16x2v_ b = __builtin_convertvector(v, bf16x2v_); return __builtin_bit_cast(unsigned, b); }
DI float bflo(unsigned u) { return __uint_as_float(u << 16); }
DI float bfhi(unsigned u) { return __uint_as_float(u & 0xffff0000u); }
DI float bf2f(unsigned short b) { return __uint_as_float((unsigned)b << 16); }
DI unsigned short f2bf1(float f) { return (unsigned short)(pk2(f, 0.f) & 0xffffu); }
DI float wave_sum(float v) {
#pragma unroll
    for (int o = 1; o < 64; o <<= 1) v += __shfl_xor(v, o);
    return v;
}
DI float silu_f(float v) { return v * __builtin_amdgcn_rcpf(1.f + __expf(-v)); }
DI int crow(int i, int h) { return (i & 3) + 8 * (i >> 2) + 4 * h; }
#define LDS_WAIT() asm volatile("s_waitcnt lgkmcnt(0)" ::: "memory")
#define MFMA32(a, b, c) __builtin_amdgcn_mfma_f32_32x32x16_bf16((a), (b), (c), 0, 0, 0)
#define MFMA16(a, b, c) __builtin_amdgcn_mfma_f32_16x16x32_bf16((a), (b), (c), 0, 0, 0)

template <class F> struct Epi8 {
    static constexpr bool PERM = true, AFTER_DRAIN = false;
    F f;
    DI void operator()(const f32x4 (&acc)[2][2][4][2], const pg8::Unit& u, int wr, int wc, int fr, int fq) const {
        const int row0 = u.pm * 256 + wr * 64 + fr, col0 = u.pn * 256 + wc * 32 + 8 * fq;
#pragma unroll
        for (int ai = 0; ai < 2; ++ai)
#pragma unroll
            for (int m = 0; m < 4; ++m)
#pragma unroll
                for (int bj = 0; bj < 2; ++bj) f(row0 + ai * 128 + m * 16, col0 + bj * 128, acc[ai][bj][m][0], acc[ai][bj][m][1]);
    }
};
DI void st8bf(bf16* p, f32x4 v0, f32x4 v1) { u32x4 w; w.x = pk2(v0[0], v0[1]); w.y = pk2(v0[2], v0[3]); w.z = pk2(v1[0], v1[1]); w.w = pk2(v1[2], v1[3]); *(u32x4*)p = w; }
DI void st8f(float* p, f32x4 v0, f32x4 v1) { *(f32x4*)p = v0; *(f32x4*)(p + 4) = v1; }

struct FInProj { bf16* PA; bf16* Z; bf16* XBC; float* DTR;
    DI void operator()(int row, int col, f32x4 v0, f32x4 v1) const {
        if (col < 704) st8bf(PA + (size_t)row * 704 + col, v0, v1);
        else if (col < 1216) st8bf(Z + (size_t)row * 512 + (col - 704), v0, v1);
        else if (col < 2240) st8bf(XBC + (size_t)row * 1024 + (col - 1216), v0, v1);
        else if (col < 2256) st8f(DTR + (size_t)row * 16 + (col - 2240), v0, v1);
    }
};
struct FQUp { bf16* Q;
    DI void operator()(int row, int col, f32x4 v0, f32x4 v1) const { st8bf(Q + (size_t)row * 768 + col, v0 * QSCALE, v1 * QSCALE); }
};
struct FBf { bf16* O; int ld; DI void operator()(int row, int col, f32x4 v0, f32x4 v1) const { st8bf(O + (size_t)row * ld + col, v0, v1); } };
struct FF32 { float* O; int ld; DI void operator()(int row, int col, f32x4 v0, f32x4 v1) const { st8f(O + (size_t)row * ld + col, v0, v1); } };
struct EpiGateUp {
    static constexpr bool PERM = true, AFTER_DRAIN = false;
    bf16* ACT;
    DI void operator()(const f32x4 (&acc)[2][2][4][2], const pg8::Unit& u, int wr, int wc, int fr, int fq) const {
        const int row0 = u.pm * 256 + wr * 64 + fr, f0 = u.pn * 128 + wc * 32 + 8 * fq;
#pragma unroll
        for (int ai = 0; ai < 2; ++ai)
#pragma unroll
            for (int m = 0; m < 4; ++m) { const f32x4 g0 = acc[ai][0][m][0], g1 = acc[ai][0][m][1], u0 = acc[ai][1][m][0], u1 = acc[ai][1][m][1];
                u32x4 w; w.x = pk2(silu_f(g0[0]) * u0[0], silu_f(g0[1]) * u0[1]); w.y = pk2(silu_f(g0[2]) * u0[2], silu_f(g0[3]) * u0[3]);
                w.z = pk2(silu_f(g1[0]) * u1[0], silu_f(g1[1]) * u1[1]); w.w = pk2(silu_f(g1[2]) * u1[2], silu_f(g1[3]) * u1[3]);
                *(u32x4*)(ACT + (size_t)(row0 + ai * 128 + m * 16) * DFF + f0) = w; }
    }
};

template <int MODE  >
DI void tr_item(const float* W, int K, int N, bf16* WT, LAS float* scr, int kb, int nb, int lane, int dst_row0) {
    const int k0 = 64 * kb, n0 = 32 * nb, nn = n0 + (lane & 31);
#pragma unroll
    for (int i = 0; i < 32; ++i) { const int kk = 2 * i + (lane >> 5); scr[kk * 33 + (lane & 31)] = (nn < N) ? __builtin_nontemporal_load(W + (size_t)(k0 + kk) * N + nn) : 0.f; }
    LDS_WAIT(); asm volatile("" ::: "memory");
    const int c = lane & 7;
#pragma unroll
    for (int j = 0; j < 4; ++j) { const int nl = (lane >> 3) + 8 * j; const LAS float* s = scr + (8 * c) * 33 + nl;
        u32x4 o; o.x = pk2(s[0 * 33], s[1 * 33]); o.y = pk2(s[2 * 33], s[3 * 33]); o.z = pk2(s[4 * 33], s[5 * 33]); o.w = pk2(s[6 * 33], s[7 * 33]);
        const int f = n0 + nl;
        const int row = (MODE == 0) ? (dst_row0 + nl) : ((f >> 7) * 256 + (MODE == 2 ? 128 : 0) + (f & 127));
        *(u32x4*)(WT + (size_t)row * K + k0 + 8 * c) = o; }
    LDS_WAIT(); asm volatile("" ::: "memory");
}

DI void phase0(LAS unsigned char* lds, const float* const* in, unsigned char* ws, int G) {
    const int tid = threadIdx.x, lane = tid & 63, wave = tid >> 6, bx = blockIdx.x;
    const float* c = in[5]; const float* c_ctx = in[6]; const float* w_mod = in[7]; const float* b_mod = in[8];
    float* mod = (float*)(ws + WS_MOD);
    if (bx < 192) {
        LAS float* sc = (LAS float*)lds;
        LAS float* red = (LAS float*)(lds + 36864);
        for (int i = tid; i < 9 * 1024; i += 512) { const int j = i >> 10, k = i & 1023; const float v = (j == 0) ? c_ctx[k] : c[(j - 1) * 1024 + k]; sc[i] = v / (1.f + expf(-v)); }
        __syncthreads();
        for (int item = bx; item < 192; item += G) {
            const int cc = tid & 31, kg = tid >> 5, col = item * 32 + cc;
            float a0 = 0.f, a1 = 0.f, a2 = 0.f, a3 = 0.f, a4 = 0.f, a5 = 0.f, a6 = 0.f, a7 = 0.f, a8 = 0.f;
#pragma unroll 16
            for (int i = 0; i < 64; ++i) { const int k = kg * 64 + i; const float w = __builtin_nontemporal_load(w_mod + (size_t)k * 6144 + col);
                a0 += sc[k] * w; a1 += sc[1024 + k] * w; a2 += sc[2048 + k] * w; a3 += sc[3072 + k] * w; a4 += sc[4096 + k] * w;
                a5 += sc[5120 + k] * w; a6 += sc[6144 + k] * w; a7 += sc[7168 + k] * w; a8 += sc[8192 + k] * w; }
            LAS float* rp = red + kg * 288 + cc;
            rp[0] = a0; rp[32] = a1; rp[64] = a2; rp[96] = a3; rp[128] = a4; rp[160] = a5; rp[192] = a6; rp[224] = a7; rp[256] = a8;
            __syncthreads();
            if (tid < 288) { const int j = tid >> 5, c2 = tid & 31; float s = b_mod[item * 32 + c2];
#pragma unroll
                for (int q = 0; q < 16; ++q) s += red[q * 288 + j * 32 + c2];
                mod[j * 6144 + item * 32 + c2] = s; }
            __syncthreads();
        }
    }
    if (bx == G - 1) {
        float* T = (float*)(ws + WS_ROPE);
        for (int e = tid; e < 1024; e += 512) { const int pos = e >> 4, i = e & 15;
            const float invf = exp2f(-(float)i * (13.287712379549449f / 16.f));
            const float ang = (float)pos * invf;
            const float n = rintf(ang * 0.15915494309189535f);
            float r = fmaf(-n, 6.28125f, ang); r = fmaf(-n, 1.9353071795864769e-3f, r);
            T[2 * e] = cosf(r); T[2 * e + 1] = sinf(r); }
    }
    __syncthreads();
    LAS float* scr = (LAS float*)(lds + 57344 + wave * 8704);
    const int gw = bx * 8 + wave, NGW = G * 8;
    constexpr int I_IN = 16 * 72, I_UQ = 6 * 24, I_KV = 4 * 32, I_OUT = 16 * 32;
    constexpr int NITEMS = I_IN + I_UQ + I_KV + I_OUT;
    for (int it = gw; it < NITEMS; it += NGW) {
        int r = it;
        if (r < I_IN) { const int kb = r / 72, nb = r % 72; tr_item<0>(in[11], 1024, IN_W, (bf16*)(ws + WS_WIN), scr, kb, nb, lane, 32 * nb); continue; } r -= I_IN;
        if (r < I_UQ) { const int kb = r / 24, nb = r % 24; tr_item<0>(in[13], 384, 768, (bf16*)(ws + WS_WUQ), scr, kb, nb, lane, 32 * nb); continue; } r -= I_UQ;
        if (r < I_KV) { const int kb = r / 32, nb = r % 32, c0 = 32 * nb, hh = c0 >> 8, e0 = c0 & 255;
            if (e0 < 128) tr_item<0>(in[15], 256, 1024, (bf16*)(ws + WS_WKN), scr, kb, nb, lane, hh * 128 + e0);
            else tr_item<0>(in[15], 256, 1024, (bf16*)(ws + WS_WV), scr, kb, nb, lane, hh * 128 + e0 - 128);
            continue; } r -= I_KV;
        { const int kb = r / 32, nb = r % 32; tr_item<0>(in[22], 1024, 1024, (bf16*)(ws + WS_WOUT), scr, kb, nb, lane, 32 * nb); }
    }
}
DI void ffn_weight_copies(LAS unsigned char* lds, const float* const* in, unsigned char* ws, int gw, int NGW) {
    const int lane = threadIdx.x & 63, wave = threadIdx.x >> 6;
    LAS float* scr = (LAS float*)(lds + 57344 + wave * 8704);
    constexpr int I_G = 16 * 88, I_DN = 44 * 32;
    for (int it = gw; it < 2 * I_G + I_DN; it += NGW) {
        int r = it;
        if (r < I_G) { const int kb = r / 88, nb = r % 88; tr_item<1>(in[25], 1024, DFF, (bf16*)(ws + WS_WGU), scr, kb, nb, lane, 0); continue; } r -= I_G;
        if (r < I_G) { const int kb = r / 88, nb = r % 88; tr_item<2>(in[26], 1024, DFF, (bf16*)(ws + WS_WGU), scr, kb, nb, lane, 0); continue; } r -= I_G;
        { const int kb = r / 32, nb = r % 32; tr_item<0>(in[27], DFF, 1024, (bf16*)(ws + WS_WDN), scr, kb, nb, lane, 32 * nb); }
    }
}

DI const float* xrow_ptr(const float* const* in, int r) { return (r < NCTX) ? in[0] + (size_t)r * DM : in[1] + (size_t)(r - NCTX) * DM; }
DI int mod_idx(int r) { return (r < NCTX) ? 0 : 1 + ((r - NCTX) >> 10); }

DI void phase1(const float* const* in, unsigned char* ws, int G) {
    const int lane = threadIdx.x & 63, wave = threadIdx.x >> 6, gw = blockIdx.x * 8 + wave, NGW = G * 8;
    const float* mod = (const float*)(ws + WS_MOD); const float* gp = in[9]; bf16* H = (bf16*)(ws + WS_H);
    f32x4 g[4];
#pragma unroll
    for (int j = 0; j < 4; ++j) g[j] = *(const f32x4*)(gp + 4 * lane + 256 * j);
    for (int r0 = gw; r0 < NTOK; r0 += 4 * NGW) {
        f32x4 v[4][4]; float s[4];
#pragma unroll
        for (int q = 0; q < 4; ++q) { const int r = r0 + q * NGW; const f32x4* xr = (const f32x4*)xrow_ptr(in, r < NTOK ? r : r0) + lane;
#pragma unroll
            for (int j = 0; j < 4; ++j) v[q][j] = __builtin_nontemporal_load(xr + 64 * j); }
#pragma unroll
        for (int q = 0; q < 4; ++q) { s[q] = 0.f;
#pragma unroll
            for (int j = 0; j < 4; ++j) s[q] += v[q][j].x * v[q][j].x + v[q][j].y * v[q][j].y + v[q][j].z * v[q][j].z + v[q][j].w * v[q][j].w; }
#pragma unroll
        for (int o = 1; o < 64; o <<= 1) {
#pragma unroll
            for (int q = 0; q < 4; ++q) s[q] += __shfl_xor(s[q], o); }
#pragma unroll
        for (int q = 0; q < 4; ++q) { const int r = r0 + q * NGW; if (r >= NTOK) break;
            const float rstd = rsqrtf(s[q] * (1.f / DM) + NORM_EPS); const float* mj = mod + mod_idx(r) * 6144;
            u32x2* o = (u32x2*)(H + (size_t)r * DM) + lane;
#pragma unroll
            for (int j = 0; j < 4; ++j) { const int k = 4 * lane + 256 * j;
                const f32x4 sc = *(const f32x4*)(mj + 1024 + k), sh = *(const f32x4*)(mj + k);
                const f32x4 h = v[q][j] * rstd * g[j] * (sc + 1.f) + sh;
                u32x2 w; w.x = pk2(h.x, h.y); w.y = pk2(h.z, h.w); o[64 * j] = w; } }
    }
}

struct P3Row { unsigned q0, q1, q2, k0, k1; unsigned short kr; u32x4 m1[2], c0[2], p1[2]; float dtr; };
DI void p3_load(P3Row& R, const bf16* PA, const bf16* XBC, const float* DTR, int r, int lane) {
    const bool ctx = r < NCTX; const int l = ctx ? (r & 255) : ((r - NCTX) & 1023), L = ctx ? 256 : 1024;
    const unsigned* pa = (const unsigned*)(PA + (size_t)r * 704);
    R.q0 = pa[lane]; R.q1 = pa[lane + 64]; R.q2 = pa[lane + 128]; R.k0 = pa[192 + lane]; R.k1 = pa[256 + lane];
    R.kr = PA[(size_t)r * 704 + 640 + lane];
    const u32x4 z4 = {0u, 0u, 0u, 0u};
#pragma unroll
    for (int jj = 0; jj < 2; ++jj) { const int ch = 8 * lane + 512 * jj;
        R.m1[jj] = (l > 0) ? *(const u32x4*)(XBC + (size_t)(r - 1) * 1024 + ch) : z4;
        R.c0[jj] = *(const u32x4*)(XBC + (size_t)r * 1024 + ch);
        R.p1[jj] = (l < L - 1) ? *(const u32x4*)(XBC + (size_t)(r + 1) * 1024 + ch) : z4; }
    R.dtr = DTR[(size_t)r * 16 + (lane & 15)];
}
DI void phase3(const float* const* in, float* out, unsigned char* ws, int G) {
    const int lane = threadIdx.x & 63, wave = threadIdx.x >> 6, gw = blockIdx.x * 8 + wave, NGW = G * 8;
    const bf16* PA = (const bf16*)(ws + WS_PA); const bf16* XBC = (const bf16*)(ws + WS_XBC);
    const float* DTR = (const float*)(ws + WS_DTR); float* DT = (float*)(ws + WS_DT);
    bf16* QN = (bf16*)(ws + WS_QN); bf16* CKV = (bf16*)(ws + WS_CKV); bf16* KR = (bf16*)(ws + WS_KR); bf16* XS = (bf16*)(ws + WS_XS);
    const float* rope = (const float*)(ws + WS_ROPE);
    const float* g_q = in[12]; const float* g_kv = in[14]; const float* conv_w = in[16]; const float* conv_b = in[17]; const float* dt_bias = in[18];
    float* out_ckv = out + 2 * (size_t)NCTX * DM; float* out_kr = out_ckv + (size_t)NCTX * 256;
    for (int rr = gw; rr < 2048; rr += NGW) {
        const int b = rr >> 8, j = rr & 255; const size_t krow = (size_t)NCTX + b * 1280 + j;
        const f32x4 v = __builtin_nontemporal_load((const f32x4*)(in[2] + (size_t)rr * 256) + lane);
        u32x2 w; w.x = pk2(v.x, v.y); w.y = pk2(v.z, v.w); *((u32x2*)(CKV + krow * 256) + lane) = w;
        KR[krow * 64 + lane] = f2bf1(in[3][(size_t)rr * 64 + lane]);
    }
    const float gq0 = g_q[2 * lane], gq1 = g_q[2 * lane + 1], gq2 = g_q[2 * lane + 128], gq3 = g_q[2 * lane + 129], gq4 = g_q[2 * lane + 256], gq5 = g_q[2 * lane + 257];
    const float gk0 = g_kv[2 * lane], gk1 = g_kv[2 * lane + 1], gk2 = g_kv[2 * lane + 128], gk3 = g_kv[2 * lane + 129];
    const float dtb = dt_bias[lane & 15];
    P3Row cur, nxt;
    if (gw < NTOK) p3_load(cur, PA, XBC, DTR, gw, lane);
    for (int r = gw; r < NTOK; r += NGW) {
        if (r + NGW < NTOK) p3_load(nxt, PA, XBC, DTR, r + NGW, lane);
        const bool ctx = r < NCTX;
        const int bl = ctx ? (r >> 8) : ((r - NCTX) >> 10), l = ctx ? (r & 255) : ((r - NCTX) & 1023);
        const size_t krow = ctx ? (size_t)r : (size_t)NCTX + bl * 1280 + 256 + l;
        { float a0 = bflo(cur.q0), a1 = bfhi(cur.q0), b0 = bflo(cur.q1), b1 = bfhi(cur.q1), c0 = bflo(cur.q2), c1 = bfhi(cur.q2);
          const float rstd = rsqrtf(wave_sum(a0 * a0 + a1 * a1 + b0 * b0 + b1 * b1 + c0 * c0 + c1 * c1) * (1.f / 384.f) + NORM_EPS);
          unsigned* q = (unsigned*)(QN + (size_t)r * 384);
          q[lane] = pk2(a0 * rstd * gq0, a1 * rstd * gq1); q[lane + 64] = pk2(b0 * rstd * gq2, b1 * rstd * gq3); q[lane + 128] = pk2(c0 * rstd * gq4, c1 * rstd * gq5); }
        { float a0 = bflo(cur.k0), a1 = bfhi(cur.k0), b0 = bflo(cur.k1), b1 = bfhi(cur.k1);
          const float rstd = rsqrtf(wave_sum(a0 * a0 + a1 * a1 + b0 * b0 + b1 * b1) * (1.f / 256.f) + NORM_EPS);
          a0 *= rstd * gk0; a1 *= rstd * gk1; b0 *= rstd * gk2; b1 *= rstd * gk3;
          unsigned* k = (unsigned*)(CKV + krow * 256); k[lane] = pk2(a0, a1); k[lane + 64] = pk2(b0, b1);
          if (ctx) { float* o = out_ckv + (size_t)r * 256; __builtin_nontemporal_store((f32x2_t){a0, a1}, (f32x2_t*)(o + 2 * lane)); __builtin_nontemporal_store((f32x2_t){b0, b1}, (f32x2_t*)(o + 2 * lane + 128)); } }
        { float v = bf2f(cur.kr);
          if (ctx) out_kr[(size_t)r * 64 + lane] = v;
          const float p = __shfl_xor(v, 16);
          if (!ctx) { const int pos = (lane < 32) ? (l >> 6) : (l & 63), idx = lane & 15; const float cs = rope[(pos * 16 + idx) * 2], sn = rope[(pos * 16 + idx) * 2 + 1];
              v = (lane & 16) ? (v * cs + p * sn) : (v * cs - p * sn); }
          KR[krow * 64 + lane] = f2bf1(v); }
#pragma unroll
        for (int jj = 0; jj < 2; ++jj) { const int ch = 8 * lane + 512 * jj;
            const f32x4 w0a = *(const f32x4*)(conv_w + ch), w0b = *(const f32x4*)(conv_w + ch + 4);
            const f32x4 w1a = *(const f32x4*)(conv_w + 1024 + ch), w1b = *(const f32x4*)(conv_w + 1024 + ch + 4);
            const f32x4 w2a = *(const f32x4*)(conv_w + 2048 + ch), w2b = *(const f32x4*)(conv_w + 2048 + ch + 4);
            const f32x4 ba = *(const f32x4*)(conv_b + ch), bb = *(const f32x4*)(conv_b + ch + 4);
            float y[8];
#pragma unroll
            for (int e = 0; e < 4; ++e) {
                const unsigned um = cur.m1[jj][e], uc = cur.c0[jj][e], up = cur.p1[jj][e];
                const float wlo0 = (e < 2) ? w0a[2 * e] : w0b[2 * e - 4], whi0 = (e < 2) ? w0a[2 * e + 1] : w0b[2 * e - 3];
                const float wlo1 = (e < 2) ? w1a[2 * e] : w1b[2 * e - 4], whi1 = (e < 2) ? w1a[2 * e + 1] : w1b[2 * e - 3];
                const float wlo2 = (e < 2) ? w2a[2 * e] : w2b[2 * e - 4], whi2 = (e < 2) ? w2a[2 * e + 1] : w2b[2 * e - 3];
                const float blo = (e < 2) ? ba[2 * e] : bb[2 * e - 4], bhi = (e < 2) ? ba[2 * e + 1] : bb[2 * e - 3];
                y[2 * e] = silu_f(blo + bflo(um) * wlo0 + bflo(uc) * wlo1 + bflo(up) * wlo2);
                y[2 * e + 1] = silu_f(bhi + bfhi(um) * whi0 + bfhi(uc) * whi1 + bfhi(up) * whi2);
            }
            u32x4 o; o.x = pk2(y[0], y[1]); o.y = pk2(y[2], y[3]); o.z = pk2(y[4], y[5]); o.w = pk2(y[6], y[7]);
            *(u32x4*)(XS + (size_t)r * 1024 + ch) = o; }
        if (lane < 16) { const float x = cur.dtr + dtb; DT[(size_t)r * 16 + lane] = fmaxf(x, 0.f) + log1pf(__expf(-fabsf(x))); }
        cur = nxt;
    }
}

struct P6Row { u32x4 yf, yb, xs, zz; };
DI void p6_load(P6Row& R, const bf16* YF, const bf16* YB, const bf16* XS, const bf16* Z, int r, int ch) {
    R.yf = *(const u32x4*)(YF + (size_t)r * 512 + ch); R.yb = *(const u32x4*)(YB + (size_t)r * 512 + ch);
    R.xs = *(const u32x4*)(XS + (size_t)r * 1024 + ch); R.zz = *(const u32x4*)(Z + (size_t)r * 512 + ch);
}
DI void phase6(const float* const* in, unsigned char* ws, int G) {
    const int lane = threadIdx.x & 63, wave = threadIdx.x >> 6, gw = blockIdx.x * 8 + wave, NGW = G * 8;
    const bf16* YF = (const bf16*)(ws + WS_YF); const bf16* YB = (const bf16*)(ws + WS_YB); const bf16* XS = (const bf16*)(ws + WS_XS); const bf16* Z = (const bf16*)(ws + WS_Z);
    bf16* MIX = (bf16*)(ws + WS_MIX); const float* d_skip = in[20]; const float* g_out = in[21];
    const int ch = 8 * lane; const float dsk = d_skip[lane >> 3];
    const f32x4 g0 = *(const f32x4*)(g_out + ch), g1 = *(const f32x4*)(g_out + ch + 4);
    P6Row cur, nxt;
    if (gw < NTOK) p6_load(cur, YF, YB, XS, Z, gw, ch);
    for (int r = gw; r < NTOK; r += NGW) {
        if (r + NGW < NTOK) p6_load(nxt, YF, YB, XS, Z, r + NGW, ch);
        float y[8]; float s = 0.f;
#pragma unroll
        for (int e = 0; e < 4; ++e) {
            const float ylo = bflo(cur.yf[e]) + bflo(cur.yb[e]) + dsk * bflo(cur.xs[e]);
            const float yhi = bfhi(cur.yf[e]) + bfhi(cur.yb[e]) + dsk * bfhi(cur.xs[e]);
            y[2 * e] = ylo * silu_f(bflo(cur.zz[e])); y[2 * e + 1] = yhi * silu_f(bfhi(cur.zz[e]));
            s += y[2 * e] * y[2 * e] + y[2 * e + 1] * y[2 * e + 1];
        }
        const float rstd = rsqrtf(wave_sum(s) * (1.f / 512.f) + NORM_EPS);
        u32x4 o; o.x = pk2(y[0] * rstd * g0[0], y[1] * rstd * g0[1]); o.y = pk2(y[2] * rstd * g0[2], y[3] * rstd * g0[3]);
        o.z = pk2(y[4] * rstd * g1[0], y[5] * rstd * g1[1]); o.w = pk2(y[6] * rstd * g1[2], y[7] * rstd * g1[3]);
        *(u32x4*)(MIX + (size_t)r * 1024 + 512 + ch) = o;
        cur = nxt;
    }
}

DI void phase8(const float* const* in, float* out, unsigned char* ws, int G) {
    const int lane = threadIdx.x & 63, wave = threadIdx.x >> 6, gw = blockIdx.x * 8 + wave, NGW = G * 8;
    const float* mod = (const float*)(ws + WS_MOD); const float* OM = (const float*)(ws + WS_OM); bf16* H = (bf16*)(ws + WS_H);
    const float* g_post = in[10]; const float* g_pre = in[23];
    for (int r = gw; r < NTOK; r += NGW) {
        const f32x4* xr = (const f32x4*)xrow_ptr(in, r) + lane; const f32x4* om = (const f32x4*)(OM + (size_t)r * DM) + lane; const float* mj = mod + mod_idx(r) * 6144;
        f32x4 v[4], y[4]; float s = 0.f;
#pragma unroll
        for (int j = 0; j < 4; ++j) { v[j] = om[64 * j]; s += v[j].x * v[j].x + v[j].y * v[j].y + v[j].z * v[j].z + v[j].w * v[j].w; }
        const float rstd = rsqrtf(wave_sum(s) * (1.f / DM) + NORM_EPS);
        float s2 = 0.f;
#pragma unroll
        for (int j = 0; j < 4; ++j) { const int k = 4 * lane + 256 * j;
            const f32x4 g = *(const f32x4*)(g_post + k), gt = *(const f32x4*)(mj + 2048 + k);
            y[j] = xr[64 * j] + gt * (v[j] * rstd * g);
            s2 += y[j].x * y[j].x + y[j].y * y[j].y + y[j].z * y[j].z + y[j].w * y[j].w;
            *((f32x4*)(out + (size_t)r * DM) + lane + 64 * j) = y[j]; }
        const float rstd2 = rsqrtf(wave_sum(s2) * (1.f / DM) + NORM_EPS);
        u32x2* o = (u32x2*)(H + (size_t)r * DM) + lane;
#pragma unroll
        for (int j = 0; j < 4; ++j) { const int k = 4 * lane + 256 * j;
            const f32x4 g = *(const f32x4*)(g_pre + k), sc = *(const f32x4*)(mj + 4096 + k), sh = *(const f32x4*)(mj + 3072 + k);
            const f32x4 h = y[j] * rstd2 * g * (sc + 1.f) + sh;
            u32x2 w; w.x = pk2(h.x, h.y); w.y = pk2(h.z, h.w); o[64 * j] = w; }
    }
}

DI void phase11(const float* const* in, float* out, unsigned char* ws, int G) {
    const int lane = threadIdx.x & 63, wave = threadIdx.x >> 6, gw = blockIdx.x * 8 + wave, NGW = G * 8;
    const float* mod = (const float*)(ws + WS_MOD); const float* F = (const float*)(ws + WS_F); const float* g_post = in[24];
    for (int r = gw; r < NTOK; r += NGW) {
        const f32x4* fr = (const f32x4*)(F + (size_t)r * DM) + lane; const float* mj = mod + mod_idx(r) * 6144;
        f32x4 v[4]; float s = 0.f;
#pragma unroll
        for (int j = 0; j < 4; ++j) { v[j] = fr[64 * j]; s += v[j].x * v[j].x + v[j].y * v[j].y + v[j].z * v[j].z + v[j].w * v[j].w; }
        const float rstd = rsqrtf(wave_sum(s) * (1.f / DM) + NORM_EPS);
#pragma unroll
        for (int j = 0; j < 4; ++j) { const int k = 4 * lane + 256 * j;
            const f32x4 g = *(const f32x4*)(g_post + k), gt = *(const f32x4*)(mj + 5120 + k);
            f32x4* o = (f32x4*)(out + (size_t)r * DM) + lane + 64 * j;
            *o = *o + gt * (v[j] * rstd * g); }
    }
}

constexpr int AK_STRIDE = 400, AV_STRIDE = 144, AV_OFF = 64 * AK_STRIDE, A_STAGE = AV_OFF + 128 * AV_STRIDE;
DI void attn_unit(LAS unsigned char* lds, const bf16* Q, const bf16* KN, const bf16* KR, const bf16* VT, bf16* MIX, const float* rope, int qrow0, int krow0, int nkt, int hh) {
    const int tid = threadIdx.x, lane = tid & 63, wave = tid >> 6, rg = wave & 3, kh = wave >> 2, r = lane & 31, hf = lane >> 5;
    bf16x8 qf[12];
    { const bf16* qp = Q + (size_t)(qrow0 + 32 * rg + r) * 768 + hh * 192 + 8 * hf;
#pragma unroll
      for (int ks = 0; ks < 12; ++ks) qf[ks] = *(const bf16x8*)(qp + 16 * ks); }
    if (rope) {
        const int l = (qrow0 + 32 * rg + r - NCTX) & 1023;
#pragma unroll
        for (int hfi = 0; hfi < 2; ++hfi) {
            const int pos = hfi ? (l & 63) : (l >> 6);
            const float* t = rope + (pos * 16 + 8 * hf) * 2;
            const u32x4 a = __builtin_bit_cast(u32x4, qf[8 + 2 * hfi]), b = __builtin_bit_cast(u32x4, qf[9 + 2 * hfi]); u32x4 ao, bo;
#pragma unroll
            for (int e = 0; e < 4; ++e) {
                const float x1l = bflo(a[e]), x1h = bfhi(a[e]), x2l = bflo(b[e]), x2h = bfhi(b[e]);
                const float c0 = t[4 * e], s0 = t[4 * e + 1], c1 = t[4 * e + 2], s1 = t[4 * e + 3];
                ao[e] = pk2(x1l * c0 - x2l * s0, x1h * c1 - x2h * s1);
                bo[e] = pk2(x2l * c0 + x1l * s0, x2h * c1 + x1h * s1);
            }
            qf[8 + 2 * hfi] = __builtin_bit_cast(bf16x8, ao); qf[9 + 2 * hfi] = __builtin_bit_cast(bf16x8, bo);
        }
    }
    f32x16 o[4];
#pragma unroll
    for (int d = 0; d < 4; ++d)
#pragma unroll
        for (int i = 0; i < 16; ++i) o[d][i] = 0.f;
    float mrun = -1e30f, lsum = 0.f;
    const int skey = tid >> 3, ssub = tid & 7, sd = tid >> 2, svs = tid & 3;
    const bf16* knp = KN + (size_t)(krow0 + skey) * 512 + hh * 128 + ssub * 8;
    const bf16* krp = KR + (size_t)(krow0 + skey) * 64 + ssub * 8;
    const bf16* vtp = VT + (size_t)(hh * 128 + sd) * NKROW + krow0 + svs * 8;
    const unsigned kdst0 = skey * AK_STRIDE + ssub * 16, vdst0 = AV_OFF + sd * AV_STRIDE + svs * 16;
    u32x4 pk[3], pv[2];
#define ATT_LOAD(kt_) do { const bf16* a_ = knp + (size_t)(kt_) * (64 * 512); pk[0] = *(const u32x4*)a_; pk[1] = *(const u32x4*)(a_ + 64); pk[2] = *(const u32x4*)(krp + (size_t)(kt_) * (64 * 64)); \
                           const bf16* v_ = vtp + (kt_) * 64; pv[0] = *(const u32x4*)v_; pv[1] = *(const u32x4*)(v_ + 32); } while (0)
#define ATT_WRITE(st_) do { LAS unsigned char* b_ = lds + (st_) * A_STAGE; *(LAS u32x4*)(b_ + kdst0) = pk[0]; *(LAS u32x4*)(b_ + kdst0 + 128) = pk[1]; *(LAS u32x4*)(b_ + kdst0 + 256) = pk[2]; \
                            *(LAS u32x4*)(b_ + vdst0) = pv[0]; *(LAS u32x4*)(b_ + vdst0 + 64) = pv[1]; } while (0)
    __syncthreads();
    ATT_LOAD(0); ATT_WRITE(0);
    if (nkt > 1) ATT_LOAD(1);
    __syncthreads();
    for (int kt = 0; kt < nkt; ++kt) {
        const int cur = kt & 1;
        if (kt + 1 < nkt) { ATT_WRITE(cur ^ 1); if (kt + 2 < nkt) ATT_LOAD(kt + 2); }
        const LAS unsigned char* stg = lds + cur * A_STAGE;
        f32x16 s;
#pragma unroll
        for (int i = 0; i < 16; ++i) s[i] = 0.f;
        {
            const LAS unsigned char* kp = stg + (32 * kh + r) * AK_STRIDE + 16 * hf;
            bf16x8 ka[4], kb[4];
#pragma unroll
            for (int i = 0; i < 4; ++i) ka[i] = *(const LAS bf16x8*)(kp + 32 * i);
#pragma unroll
            for (int i = 0; i < 4; ++i) kb[i] = *(const LAS bf16x8*)(kp + 32 * (4 + i));
            __builtin_amdgcn_sched_barrier(0);
#pragma unroll
            for (int i = 0; i < 4; ++i) s = MFMA32(ka[i], qf[i], s);
#pragma unroll
            for (int i = 0; i < 4; ++i) ka[i] = *(const LAS bf16x8*)(kp + 32 * (8 + i));
            __builtin_amdgcn_sched_barrier(0);
#pragma unroll
            for (int i = 0; i < 4; ++i) s = MFMA32(kb[i], qf[4 + i], s);
#pragma unroll
            for (int i = 0; i < 4; ++i) s = MFMA32(ka[i], qf[8 + i], s);
        }
        const LAS unsigned char* vbase = stg + AV_OFF + r * AV_STRIDE + (32 * kh + 4 * hf) * 2;
        s16x4 vlo[4], vhi[4];
#pragma unroll
        for (int d = 0; d < 4; ++d) { vlo[d] = *(const LAS s16x4*)(vbase + 32 * d * AV_STRIDE); vhi[d] = *(const LAS s16x4*)(vbase + 32 * d * AV_STRIDE + 16); }
        __builtin_amdgcn_sched_barrier(0);
        float mx = s[0];
#pragma unroll
        for (int i = 1; i < 16; ++i) mx = fmaxf(mx, s[i]);
        mx = fmaxf(mx, __shfl_xor(mx, 32));
        const float mnew = fmaxf(mrun, mx), alpha = __builtin_amdgcn_exp2f(mrun - mnew); mrun = mnew;
        float ps = 0.f;
#pragma unroll
        for (int i = 0; i < 16; ++i) { s[i] = __builtin_amdgcn_exp2f(s[i] - mnew); ps += s[i]; }
        lsum = lsum * alpha + ps;
#pragma unroll
        for (int d = 0; d < 4; ++d)
#pragma unroll
            for (int i = 0; i < 16; ++i) o[d][i] *= alpha;
        {
            u32x4 pw; pw.x = pk2(s[0], s[1]); pw.y = pk2(s[2], s[3]); pw.z = pk2(s[4], s[5]); pw.w = pk2(s[6], s[7]);
            const bf16x8 pf = __builtin_bit_cast(bf16x8, pw);
            bf16x8 vf[4];
#pragma unroll
            for (int d = 0; d < 4; ++d) vf[d] = __builtin_shufflevector(vlo[d], vhi[d], 0, 1, 2, 3, 4, 5, 6, 7);
#pragma unroll
            for (int d = 0; d < 4; ++d) { vlo[d] = *(const LAS s16x4*)(vbase + 32 * d * AV_STRIDE + 32); vhi[d] = *(const LAS s16x4*)(vbase + 32 * d * AV_STRIDE + 48); }
            __builtin_amdgcn_sched_barrier(0);
#pragma unroll
            for (int d = 0; d < 4; ++d) o[d] = MFMA32(vf[d], pf, o[d]);
        }
        {
            u32x4 pw; pw.x = pk2(s[8], s[9]); pw.y = pk2(s[10], s[11]); pw.z = pk2(s[12], s[13]); pw.w = pk2(s[14], s[15]);
            const bf16x8 pf = __builtin_bit_cast(bf16x8, pw);
#pragma unroll
            for (int d = 0; d < 4; ++d) { const bf16x8 vf = __builtin_shufflevector(vlo[d], vhi[d], 0, 1, 2, 3, 4, 5, 6, 7); o[d] = MFMA32(vf, pf, o[d]); }
        }
        __syncthreads();
    }
#undef ATT_LOAD
#undef ATT_WRITE
    lsum += __shfl_xor(lsum, 32);
    LAS float* Mg = (LAS float*)lds + rg * 4096; LAS float* ml = (LAS float*)(lds + 65536) + rg * 128;
    if (kh == 1) {
#pragma unroll
        for (int d = 0; d < 4; ++d)
#pragma unroll
            for (int i = 0; i < 16; ++i) Mg[(d * 16 + i) * 64 + lane] = o[d][i];
        ml[lane] = mrun; ml[64 + lane] = lsum;
    }
    __syncthreads();
    if (kh == 0) {
        const float m1 = ml[lane], l1 = ml[64 + lane], m = fmaxf(mrun, m1), a0 = __builtin_amdgcn_exp2f(mrun - m), a1 = __builtin_amdgcn_exp2f(m1 - m);
        const float inv = 1.f / (lsum * a0 + l1 * a1), w0 = a0 * inv, w1 = a1 * inv;
        bf16* op = MIX + (size_t)(qrow0 + 32 * rg + r) * 1024 + hh * 128 + 4 * hf;
#pragma unroll
        for (int d = 0; d < 4; ++d)
#pragma unroll
            for (int ig = 0; ig < 4; ++ig) { float v[4];
#pragma unroll
                for (int e = 0; e < 4; ++e) v[e] = o[d][4 * ig + e] * w0 + Mg[(d * 16 + 4 * ig + e) * 64 + lane] * w1;
                u32x2 w; w.x = pk2(v[0], v[1]); w.y = pk2(v[2], v[3]); *(u32x2*)(op + 32 * d + 8 * ig) = w; }
    }
}

constexpr int SS = 272;
constexpr int S_BS = 0, S_CS = 34816, S_BT = 69632, S_XT = 104448, S_SB = 121856, S_ACS = 139264, S_DT = 139776;
DI void ssd_item(LAS unsigned char* lds, const bf16* XS, const float* DT, const float* a_log, const float* st_in, float* st_out, bf16* Y, int row0, int L, int h, int dir) {
    const int tid = threadIdx.x, lane = tid & 63, wave = tid >> 6, r = lane & 31, hf = lane >> 5, pt = wave & 1, lt = (wave < 4) ? (wave >> 1) : (3 - ((wave - 4) >> 1));
    const int grp = h >> 2;
    const float a = -expf(a_log[dir * 8 + h]);
    LAS float* acs = (LAS float*)(lds + S_ACS); LAS float* dts = (LAS float*)(lds + S_DT);
    f32x16 S;
#pragma unroll
    for (int i = 0; i < 16; ++i) S[i] = st_in ? st_in[(size_t)(32 * pt + crow(i, hf)) * 128 + 32 * lt + r] : 0.f;
    const int nch = L >> 7;
    u32x4 vb[4], vc[4], vx[2]; float d0 = 0.f, d1 = 0.f;
    const int pcol = tid & 15, prow = tid >> 4, xcol = tid & 7, xrow = tid >> 3;
#define SSD_LOAD(ch_) do { \
        _Pragma("unroll") for (int k = 0; k < 4; ++k) { const int i0 = 128 * (ch_) + prow + 32 * k, t = dir ? (L - 1 - i0) : i0; \
            const bf16* rpb = XS + (size_t)(row0 + t) * 1024 + 512 + grp * 128 + 8 * pcol; vb[k] = *(const u32x4*)rpb; vc[k] = *(const u32x4*)(rpb + 256); } \
        _Pragma("unroll") for (int k = 0; k < 2; ++k) { const int i0 = 128 * (ch_) + xrow + 64 * k, t = dir ? (L - 1 - i0) : i0; \
            vx[k] = *(const u32x4*)(XS + (size_t)(row0 + t) * 1024 + h * 64 + 8 * xcol); } \
        if (wave == 0) { const int i0 = 128 * (ch_) + 2 * lane, t0 = dir ? (L - 1 - i0) : i0, t1 = dir ? (t0 - 1) : (t0 + 1); \
            d0 = DT[(size_t)(row0 + t0) * 16 + dir * 8 + h]; d1 = DT[(size_t)(row0 + t1) * 16 + dir * 8 + h]; } } while (0)
    for (int ch = 0; ch < nch; ++ch) {
        SSD_LOAD(ch);
        __syncthreads();
        if (wave == 0) {
            const float x0 = d0 * a, x1 = d1 * a; float v = x0 + x1;
#pragma unroll
            for (int o = 1; o < 64; o <<= 1) { const float n = __shfl_up(v, o); if (lane >= o) v += n; }
            acs[2 * lane] = v - x1; acs[2 * lane + 1] = v; dts[2 * lane] = d0; dts[2 * lane + 1] = d1;
        }
#pragma unroll
        for (int i = 0; i < 16; ++i) *(LAS unsigned short*)(lds + S_SB + (32 * pt + crow(i, hf)) * SS + (32 * lt + r) * 2) = f2bf1(S[i]);
        __syncthreads();
        const float acs_last = acs[127];
#pragma unroll
        for (int k = 0; k < 4; ++k) { const int l = prow + 32 * k;
            *(LAS u32x4*)(lds + S_BS + l * SS + pcol * 16) = vb[k]; *(LAS u32x4*)(lds + S_CS + l * SS + pcol * 16) = vc[k];
            const float wB = __expf(acs_last - acs[l]);
            LAS unsigned char* colb = lds + S_BT + (8 * pcol) * SS + ((((l >> 3) ^ pcol) << 3) + (l & 7)) * 2;
#pragma unroll
            for (int e = 0; e < 4; ++e) { const unsigned u = pk2(bflo(vb[k][e]) * wB, bfhi(vb[k][e]) * wB);
                *(LAS unsigned short*)(colb + (2 * e) * SS) = (unsigned short)(u & 0xffffu);
                *(LAS unsigned short*)(colb + (2 * e + 1) * SS) = (unsigned short)(u >> 16); } }
#pragma unroll
        for (int k = 0; k < 2; ++k) { const int l = xrow + 64 * k; const float wX = dts[l];
            LAS unsigned char* colb = lds + S_XT + (8 * xcol) * SS + ((((l >> 3) ^ xcol) << 3) + (l & 7)) * 2;
#pragma unroll
            for (int e = 0; e < 4; ++e) { const unsigned u = pk2(bflo(vx[k][e]) * wX, bfhi(vx[k][e]) * wX);
                *(LAS unsigned short*)(colb + (2 * e) * SS) = (unsigned short)(u & 0xffffu);
                *(LAS unsigned short*)(colb + (2 * e + 1) * SS) = (unsigned short)(u >> 16); } }
        __syncthreads();
        bf16x8 cf[8];
#pragma unroll
        for (int ks = 0; ks < 8; ++ks) cf[ks] = *(const LAS bf16x8*)(lds + S_CS + (32 * lt + r) * SS + (16 * ks + 8 * hf) * 2);
        const float acs_l = acs[32 * lt + r]; const int lcol = 32 * lt + r;
        const int cX = (4 * pt + (r >> 3)) & 7, cB = (4 * lt + (r >> 3)) & 15;
        f32x16 Yd;
#pragma unroll
        for (int i = 0; i < 16; ++i) Yd[i] = 0.f;
        for (int st = 0; st <= lt; ++st) {
            f32x16 cb;
#pragma unroll
            for (int i = 0; i < 16; ++i) cb[i] = 0.f;
            { bf16x8 bfr[8]; const LAS unsigned char* bp = lds + S_BS + (32 * st + r) * SS + 16 * hf;
#pragma unroll
              for (int ks = 0; ks < 8; ++ks) bfr[ks] = *(const LAS bf16x8*)(bp + 32 * ks);
              __builtin_amdgcn_sched_barrier(0);
#pragma unroll
              for (int ks = 0; ks < 8; ++ks) cb = MFMA32(bfr[ks], cf[ks], cb); }
            s16x4 xlo[2], xhi[2]; float av[16];
#pragma unroll
            for (int u = 0; u < 2; ++u) { const LAS unsigned char* xp = lds + S_XT + (32 * pt + r) * SS + 8 * hf; const int lg = 4 * st + 2 * u;
                xlo[u] = *(const LAS s16x4*)(xp + ((lg ^ cX) << 4)); xhi[u] = *(const LAS s16x4*)(xp + (((lg + 1) ^ cX) << 4)); }
#pragma unroll
            for (int i = 0; i < 16; ++i) av[i] = acs[32 * st + crow(i, hf)];
#pragma unroll
            for (int i = 0; i < 16; ++i) { const int sidx = 32 * st + crow(i, hf); const float e = __expf(acs_l - av[i]); cb[i] = (sidx <= lcol) ? cb[i] * e : 0.f; }
#pragma unroll
            for (int u = 0; u < 2; ++u) {
                u32x4 pw; pw.x = pk2(cb[8 * u], cb[8 * u + 1]); pw.y = pk2(cb[8 * u + 2], cb[8 * u + 3]); pw.z = pk2(cb[8 * u + 4], cb[8 * u + 5]); pw.w = pk2(cb[8 * u + 6], cb[8 * u + 7]);
                const bf16x8 pf = __builtin_bit_cast(bf16x8, pw);
                const bf16x8 xa = __builtin_shufflevector(xlo[u], xhi[u], 0, 1, 2, 3, 4, 5, 6, 7);
                Yd = MFMA32(xa, pf, Yd);
            }
        }
        f32x16 Yo;
#pragma unroll
        for (int i = 0; i < 16; ++i) Yo[i] = 0.f;
        { bf16x8 sa[8]; const LAS unsigned char* sp = lds + S_SB + (32 * pt + r) * SS + 16 * hf;
#pragma unroll
          for (int ks = 0; ks < 8; ++ks) sa[ks] = *(const LAS bf16x8*)(sp + 32 * ks);
          __builtin_amdgcn_sched_barrier(0);
#pragma unroll
          for (int ks = 0; ks < 8; ++ks) Yo = MFMA32(sa[ks], cf[ks], Yo); }
        { const float el = __expf(acs_l); const int i0 = 128 * ch + lcol, t = dir ? (L - 1 - i0) : i0;
          bf16* yp = Y + (size_t)(row0 + t) * 512 + h * 64 + 32 * pt + 4 * hf;
#pragma unroll
          for (int ig = 0; ig < 4; ++ig) { u32x2 v; v.x = pk2(Yd[4 * ig] + el * Yo[4 * ig], Yd[4 * ig + 1] + el * Yo[4 * ig + 1]); v.y = pk2(Yd[4 * ig + 2] + el * Yo[4 * ig + 2], Yd[4 * ig + 3] + el * Yo[4 * ig + 3]);
              *(u32x2*)(yp + 8 * ig) = v; } }
        { const float dl = __expf(acs_last);
#pragma unroll
          for (int i = 0; i < 16; ++i) S[i] *= dl;
          const LAS unsigned char* xp2 = lds + S_XT + (32 * pt + r) * SS; const LAS unsigned char* bp2 = lds + S_BT + (32 * lt + r) * SS;
#pragma unroll
          for (int half = 0; half < 2; ++half) { bf16x8 xa[4], bb[4];
#pragma unroll
              for (int k = 0; k < 4; ++k) { const int lg = 2 * (4 * half + k) + hf; xa[k] = *(const LAS bf16x8*)(xp2 + ((lg ^ cX) << 4)); bb[k] = *(const LAS bf16x8*)(bp2 + ((lg ^ cB) << 4)); }
              __builtin_amdgcn_sched_barrier(0);
#pragma unroll
              for (int k = 0; k < 4; ++k) S = MFMA32(xa[k], bb[k], S); } }
    }
#undef SSD_LOAD
    if (st_out) {
#pragma unroll
        for (int i = 0; i < 16; ++i) st_out[(size_t)(32 * pt + crow(i, hf)) * 128 + 32 * lt + r] = S[i];
    }
}

DI void phase5(LAS unsigned char* lds, const float* const* in, float* out, unsigned char* ws, int G) {
    const bf16* Q = (const bf16*)(ws + WS_Q); const bf16* KN = (const bf16*)(ws + WS_KN); const bf16* KR = (const bf16*)(ws + WS_KR); const bf16* VT = (const bf16*)(ws + WS_VT);
    bf16* MIX = (bf16*)(ws + WS_MIX);
    const int bxl = (int)blockIdx.x, vb = (G == 256) ? ((bxl & 7) * 32 + (bxl >> 3)) : bxl;
    for (int u = vb; u < 512; u += G) {
        if (u < 256) { const int b = u >> 5, hh = (u >> 3) & 3, qb = u & 7; attn_unit(lds, Q, KN, KR, VT, MIX, (const float*)(ws + WS_ROPE), NCTX + b * 1024 + qb * 128, NCTX + b * 1280, 20, hh); }
        else { const int v = u - 256, b = v >> 3, hh = (v >> 1) & 3, qb = v & 1; attn_unit(lds, Q, KN, KR, VT, MIX, nullptr, b * 256 + qb * 128, b * 256, 4, hh); }
    }
    const bf16* XS = (const bf16*)(ws + WS_XS); const float* DT = (const float*)(ws + WS_DT); const float* a_log = in[19];
    bf16* YF = (bf16*)(ws + WS_YF); bf16* YB = (bf16*)(ws + WS_YB);
    float* out_st = out + 2 * (size_t)NCTX * DM + (size_t)NCTX * 256 + (size_t)NCTX * 64;
    const int vs = (G == 256) ? (((bxl >> 3) < 16) ? ((bxl & 7) * 16 + (bxl >> 3)) : (128 + (bxl & 7) * 16 + (bxl >> 3) - 16)) : bxl;
    for (int s = vs; s < 256; s += G) {
        if (s < 128) { const int b = s >> 4, h = (s >> 1) & 7, dir = s & 1;
            ssd_item(lds, XS, DT, a_log, in[4] + ((size_t)(b * 2 + dir) * 8 + h) * 8192, nullptr, dir ? YB : YF, NCTX + b * 1024, 1024, h, dir); }
        else { for (int k = 0; k < 4; ++k) { const int it = (s - 128) * 4 + k, b = it >> 4, h = (it >> 1) & 7, dir = it & 1;
            ssd_item(lds, XS, DT, a_log, nullptr, out_st + ((size_t)(b * 2 + dir) * 8 + h) * 8192, dir ? YB : YF, b * 256, 256, h, dir); } }
    }
}

#define XB_TMO      128
#define XB_XCNT(j)  (256  + 64 * (j))
#define XB_XSUB(j)  (1280 + 64 * (j))
#define XB_XGEN(j)  (2304 + 64 * (j))
#define XB_TOP      3328
#define XB_TOPGEN   3392
#define XCD_BAR_WORDS 3456
#define XB_SPIN_CAP (1u << 18)
__device__ __forceinline__ unsigned xb_ld(unsigned* p)              { return __hip_atomic_load(p, __ATOMIC_RELAXED, __HIP_MEMORY_SCOPE_AGENT); }
__device__ __forceinline__ unsigned xb_add(unsigned* p, unsigned v) { return __hip_atomic_fetch_add(p, v, __ATOMIC_RELAXED, __HIP_MEMORY_SCOPE_AGENT); }
__device__ __forceinline__ unsigned xb_xcc_id() { return (unsigned)__builtin_amdgcn_s_getreg((3 << 11) | 20) & 0xFu; }
#define XB_SPIN(cond, bar) do { unsigned _sp = 0; while (cond) { __builtin_amdgcn_s_sleep(1); \
    if ((++_sp & 255u) == 0u) { if (xb_ld(&(bar)[XB_TMO])) break; if (_sp > XB_SPIN_CAP) { atomicAdd(&(bar)[XB_TMO], 1u); break; } } } } while (0)
struct XcdBarrier { unsigned* bar; unsigned x; volatile LAS unsigned* st; };
__device__ __forceinline__ XcdBarrier xcd_barrier_post(unsigned* bar, volatile LAS unsigned* st) {
    XcdBarrier b; b.bar = bar; b.x = xb_xcc_id(); b.st = st;
    if (threadIdx.x == 0) (void)xb_add(&bar[XB_XCNT(b.x)], 1u);
    return b;
}
__device__ __forceinline__ void xcd_barrier_complete(unsigned* bar, unsigned x, unsigned& nloc, unsigned& nx) {
    const unsigned G = gridDim.x * gridDim.y * gridDim.z;
    unsigned sum, cnt, mine, sp = 0u;
    for (;;) {
        sum = 0u; cnt = 0u; mine = 0u;
#pragma unroll
        for (unsigned j = 0; j < 16; ++j) { const unsigned c = xb_ld(&bar[XB_XCNT(j)]); sum += c; cnt += (c > 0u) ? 1u : 0u; mine = (j == x) ? c : mine; }
        if (sum == G) break;
        __builtin_amdgcn_s_sleep(1);
        if ((++sp & 255u) == 0u) { if (xb_ld(&bar[XB_TMO])) break; if (sp > XB_SPIN_CAP) { atomicAdd(&bar[XB_TMO], 1u); break; } }
    }
    nloc = mine > 0u ? mine : 1u; nx = cnt > 0u ? cnt : 1u;
}
__device__ __forceinline__ void xcd_barrier(const XcdBarrier& b) {
    asm volatile("s_waitcnt vmcnt(0)" ::: "memory");
    __syncthreads();
    if (threadIdx.x == 0) {
        unsigned* bar = b.bar;
        __builtin_amdgcn_s_waitcnt(0);
        unsigned nloc = b.st[0], nx = b.st[1];
        if (nloc == 0u) { xcd_barrier_complete(bar, b.x, nloc, nx); b.st[0] = nloc; b.st[1] = nx; }
        const unsigned old = xb_add(&bar[XB_XSUB(b.x)], 1u);
        const unsigned gen = old / nloc;
        if (old + 1u == (gen + 1u) * nloc) {
            __builtin_amdgcn_fence(__ATOMIC_RELEASE, "agent");
            asm volatile("s_waitcnt vmcnt(0)" ::: "memory");
            const unsigned og = xb_add(&bar[XB_TOP], 1u);
            const unsigned tg = og / nx;
            if (og + 1u == (tg + 1u) * nx) xb_add(&bar[XB_TOPGEN], 1u);
            else XB_SPIN(xb_ld(&bar[XB_TOPGEN]) == tg, bar);
            __builtin_amdgcn_fence(__ATOMIC_ACQUIRE, "agent");
            xb_add(&bar[XB_XGEN(b.x)], 1u);
            asm volatile("s_waitcnt vmcnt(0)" ::: "memory");
        } else {
            XB_SPIN(xb_ld(&bar[XB_XGEN(b.x)]) == gen, bar);
            __builtin_amdgcn_fence(__ATOMIC_ACQUIRE, "agent");
            asm volatile("s_waitcnt vmcnt(0)" ::: "memory");
        }
    }
    __syncthreads();
}
constexpr int LDS_BAR_OFF = 147392;
constexpr size_t CTL_ZERO_BYTES = 65536;

constexpr size_t WS_PS1 = 128 * 1024, WS_PS2 = 384 * 1024, WS_PS3 = 640 * 1024;
DI void panel_sumsq(const f32x4 (&acc)[2][2][4][2], LAS float* red, float* PS, const pg8::Unit& u, int wr, int wc, int fr, int fq) {
#pragma unroll
    for (int ai = 0; ai < 2; ++ai)
#pragma unroll
        for (int m = 0; m < 4; ++m) { float s = 0.f;
#pragma unroll
            for (int bj = 0; bj < 2; ++bj)
#pragma unroll
                for (int n = 0; n < 2; ++n)
#pragma unroll
                    for (int i = 0; i < 4; ++i) s += acc[ai][bj][m][n][i] * acc[ai][bj][m][n][i];
            s += __shfl_xor(s, 16); s += __shfl_xor(s, 32);
            if (fq == 0) red[wc * 256 + ai * 128 + wr * 64 + m * 16 + fr] = s; }
    __syncthreads();
    if (threadIdx.x < 256) { const int t = threadIdx.x; PS[u.pn * NTOK + u.pm * 256 + t] = red[t] + red[256 + t] + red[512 + t] + red[768 + t]; }
}
DI void panel_rstd(LAS float* rs, const float* PS, const pg8::Unit& u) {
    if (threadIdx.x < 256) { const int row = u.pm * 256 + threadIdx.x; rs[threadIdx.x] = rsqrtf((PS[row] + PS[NTOK + row] + PS[2 * NTOK + row] + PS[3 * NTOK + row]) * (1.f / DM) + NORM_EPS); }
    __syncthreads();
}
struct EpiMixFused {
    static constexpr bool PERM = true, AFTER_DRAIN = true;
    const float* x0; const float* x1; bf16* Y1; bf16* H; const float* mod; const float* g_post; const float* g_pre; float* PS1; float* PS2; XcdBarrier bar;
    DI void operator()(const f32x4 (&)[2][2][4][2], const pg8::Unit&, int, int, int, int) const {}
    DI void fused(f32x4 (&acc)[2][2][4][2], const pg8::Unit& u, int wr, int wc, int fr, int fq, LAS unsigned char* lds, int wid, int lane) const {
        LAS float* red = (LAS float*)lds; LAS float* rs = (LAS float*)(lds + 4096);
        const int row0 = u.pm * 256 + wr * 64 + fr, col0 = u.pn * 256 + wc * 32 + 8 * fq;
        const float* mj = mod + mod_idx(u.pm * 256) * 6144;
        panel_sumsq(acc, red, PS1, u, wr, wc, fr, fq);
        xcd_barrier(bar);
        panel_rstd(rs, PS1, u);
#pragma unroll
        for (int bj = 0; bj < 2; ++bj) { const int col = col0 + bj * 128;
            const f32x4 ca = *(const f32x4*)(mj + 2048 + col) * *(const f32x4*)(g_post + col), cb = *(const f32x4*)(mj + 2048 + col + 4) * *(const f32x4*)(g_post + col + 4);
#pragma unroll
            for (int ai = 0; ai < 2; ++ai)
#pragma unroll
                for (int m = 0; m < 4; ++m) { const int row = row0 + ai * 128 + m * 16; const float r = rs[ai * 128 + wr * 64 + m * 16 + fr];
                    const float* xr = ((row < NCTX) ? x0 + (size_t)row * DM : x1 + (size_t)(row - NCTX) * DM) + col;
                    const f32x4 y0 = __builtin_nontemporal_load((const f32x4*)xr) + ca * (acc[ai][bj][m][0] * r), y1 = __builtin_nontemporal_load((const f32x4*)(xr + 4)) + cb * (acc[ai][bj][m][1] * r);
                    acc[ai][bj][m][0] = y0; acc[ai][bj][m][1] = y1;
                    st8bf(Y1 + (size_t)row * DM + col, y0, y1); } }
        panel_sumsq(acc, red, PS2, u, wr, wc, fr, fq);
        xcd_barrier(bar);
        panel_rstd(rs, PS2, u);
#pragma unroll
        for (int bj = 0; bj < 2; ++bj) { const int col = col0 + bj * 128;
            const f32x4 ga = *(const f32x4*)(g_pre + col) * (*(const f32x4*)(mj + 4096 + col) + 1.f), gb = *(const f32x4*)(g_pre + col + 4) * (*(const f32x4*)(mj + 4096 + col + 4) + 1.f);
            const f32x4 sa = *(const f32x4*)(mj + 3072 + col), sb = *(const f32x4*)(mj + 3072 + col + 4);
#pragma unroll
            for (int ai = 0; ai < 2; ++ai)
#pragma unroll
                for (int m = 0; m < 4; ++m) { const int row = row0 + ai * 128 + m * 16; const float r = rs[ai * 128 + wr * 64 + m * 16 + fr];
                    st8bf(H + (size_t)row * DM + col, acc[ai][bj][m][0] * r * ga + sa, acc[ai][bj][m][1] * r * gb + sb); } }
    }
};
struct EpiFfnFused {
    static constexpr bool PERM = true, AFTER_DRAIN = true;
    float* out; const bf16* Y1; const float* mod; const float* g_post; float* PS; XcdBarrier bar;
    DI void operator()(const f32x4 (&)[2][2][4][2], const pg8::Unit&, int, int, int, int) const {}
    DI void fused(f32x4 (&acc)[2][2][4][2], const pg8::Unit& u, int wr, int wc, int fr, int fq, LAS unsigned char* lds, int wid, int lane) const {
        LAS float* red = (LAS float*)lds; LAS float* rs = (LAS float*)(lds + 4096);
        const int row0 = u.pm * 256 + wr * 64 + fr, col0 = u.pn * 256 + wc * 32 + 8 * fq;
        const float* mj = mod + mod_idx(u.pm * 256) * 6144;
        panel_sumsq(acc, red, PS, u, wr, wc, fr, fq);
        xcd_barrier(bar);
        panel_rstd(rs, PS, u);
#pragma unroll
        for (int bj = 0; bj < 2; ++bj) { const int col = col0 + bj * 128;
            const f32x4 ca = *(const f32x4*)(mj + 5120 + col) * *(const f32x4*)(g_post + col), cb = *(const f32x4*)(mj + 5120 + col + 4) * *(const f32x4*)(g_post + col + 4);
#pragma unroll
            for (int ai = 0; ai < 2; ++ai)
#pragma unroll
                for (int m = 0; m < 4; ++m) { const int row = row0 + ai * 128 + m * 16; const float r = rs[ai * 128 + wr * 64 + m * 16 + fr];
                    float* o = out + (size_t)row * DM + col; const u32x4 yv = *(const u32x4*)(Y1 + (size_t)row * DM + col);
                    const f32x4 ya = {bflo(yv.x), bfhi(yv.x), bflo(yv.y), bfhi(yv.y)}, yb = {bflo(yv.z), bfhi(yv.z), bflo(yv.w), bfhi(yv.w)};
                    __builtin_nontemporal_store(ya + ca * (acc[ai][bj][m][0] * r), (f32x4*)o); __builtin_nontemporal_store(yb + cb * (acc[ai][bj][m][1] * r), (f32x4*)(o + 4)); } }
    }
};

struct Args { const float* in[28]; float* out; unsigned char* ws; int ph_lo, ph_hi; };
constexpr int NPHASE = 12;

__global__ void __launch_bounds__(512, 2) mk_fwd(Args args) {
    extern __shared__ __attribute__((aligned(16))) unsigned char lds_raw[];
    LAS unsigned char* lds = (LAS unsigned char*)lds_raw;
    const int G = gridDim.x, bx = blockIdx.x;
    unsigned char* ws = args.ws; float* out = args.out; const float* const* in = args.in;
    const int lo = args.ph_lo, hi = args.ph_hi;
    volatile LAS unsigned* bst = (volatile LAS unsigned*)(lds + LDS_BAR_OFF);
    if (threadIdx.x < 2) bst[threadIdx.x] = 0u;
    __syncthreads();
    XcdBarrier bar; bar.bar = (unsigned*)ws; bar.x = 0; bar.st = bst;
    if (hi - lo > 1) bar = xcd_barrier_post((unsigned*)ws, bst);
#ifndef P4SEL
#define P4SEL 7
#endif
#ifndef DUPMASK
#define DUPMASK 0
#endif
#define REP(k) for (int rep_ = 0; rep_ < 1 + ((DUPMASK >> (k)) & 1); ++rep_)
#ifndef PHMASK
#define PHMASK 0xfff
#endif
#define IN(k) (((PHMASK >> (k)) & 1) && lo <= (k) && (k) < hi)
#define SEAM(k) do { if (hi - lo > 1) { xcd_barrier(bar); } } while (0)
    typedef pg8::StaticOrder SO;
    if (IN(0)) REP(0) { phase0(lds, in, ws, G); __syncthreads(); }
    SEAM(0);
    if (IN(1)) REP(1) phase1(in, ws, G);
    SEAM(1);
    if (IN(2)) REP(2) {
        __syncthreads();
        pg8::Gemm g{(const bf16*)(ws + WS_H), (const bf16*)(ws + WS_WIN), NTOK, IN_WP, 1024}; SO S; S.init(NTOK, IN_WP, G, bx);
        Epi8<FInProj> E{{(bf16*)(ws + WS_PA), (bf16*)(ws + WS_Z), (bf16*)(ws + WS_XBC), (float*)(ws + WS_DTR)}};
        pg8::gemm_phase<Epi8<FInProj>, SO, true, true>(lds, g, S, E);
        if (G == 256) { if (bx >= 64) ffn_weight_copies(lds, in, ws, (bx - 64) * 8 + (int)(threadIdx.x >> 6), 192 * 8); }
        else ffn_weight_copies(lds, in, ws, bx * 8 + (int)(threadIdx.x >> 6), G * 8);
    }
    SEAM(2);
    if (IN(3)) REP(3) phase3(in, out, ws, G);
    SEAM(3);
    if (IN(4)) REP(4) {
        __syncthreads();
#if P4SEL & 1
        { pg8::Gemm g{(const bf16*)(ws + WS_QN), (const bf16*)(ws + WS_WUQ), NTOK, 768, 384}; SO S; S.init(NTOK, 768, G, bx);
          Epi8<FQUp> E{{(bf16*)(ws + WS_Q)}};
          pg8::gemm_phase<Epi8<FQUp>, SO, true, true>(lds, g, S, E); }
#endif
#if P4SEL & 2
        __syncthreads();
        { pg8::Gemm g{(const bf16*)(ws + WS_CKV), (const bf16*)(ws + WS_WKN), NKROW, 512, 256}; SO S; S.init(NKROW, 512, G, (bx + 64) % G);
          Epi8<FBf> E{{(bf16*)(ws + WS_KN), 512}};
          pg8::gemm_phase<Epi8<FBf>, SO, true, true>(lds, g, S, E); }
#endif
#if P4SEL & 4
        __syncthreads();
        { pg8::Gemm g{(const bf16*)(ws + WS_WV), (const bf16*)(ws + WS_CKV), 512, NKROW, 256}; SO S; S.init(512, NKROW, G, (bx + 176) % G);
          Epi8<FBf> E{{(bf16*)(ws + WS_VT), NKROW}};
          pg8::gemm_phase<Epi8<FBf>, SO, true, true>(lds, g, S, E); }
#endif
    }
    SEAM(4);
    if (IN(5)) phase5(lds, in, out, ws, G);
    SEAM(5);
    if (IN(6)) REP(6) phase6(in, ws, G);
    SEAM(6);
    if (IN(7)) {
        pg8::Gemm g{(const bf16*)(ws + WS_MIX), (const bf16*)(ws + WS_WOUT), NTOK, 1024, 1024}; SO S; S.init(NTOK, 1024, G, bx);
        EpiMixFused E{in[0], in[1], (bf16*)(ws + WS_Y1), (bf16*)(ws + WS_H), (const float*)(ws + WS_MOD), in[10], in[23], (float*)(ws + WS_PS1), (float*)(ws + WS_PS2), bar};
        pg8::gemm_phase<EpiMixFused, SO, false, true>(lds, g, S, E);
    }
    SEAM(7);
    if (IN(9)) REP(9) {
        __syncthreads();
        pg8::Gemm g{(const bf16*)(ws + WS_H), (const bf16*)(ws + WS_WGU), NTOK, 2 * DFF, 1024}; SO S; S.init(NTOK, 2 * DFF, G, bx);
        EpiGateUp E{(bf16*)(ws + WS_ACT)};
        pg8::gemm_phase<EpiGateUp, SO, true, true>(lds, g, S, E);
    }
    SEAM(9);
    if (IN(10)) {
        pg8::Gemm g{(const bf16*)(ws + WS_ACT), (const bf16*)(ws + WS_WDN), NTOK, 1024, DFF}; SO S; S.init(NTOK, 1024, G, bx);
        EpiFfnFused E{out, (const bf16*)(ws + WS_Y1), (const float*)(ws + WS_MOD), in[24], (float*)(ws + WS_PS3), bar};
        pg8::gemm_phase<EpiFfnFused, SO, false, true>(lds, g, S, E);
    }
#undef IN
#undef SEAM
}

extern "C" void kernel_launch(void* const* d_in, const int* in_sizes, int n_in, void* d_out, int out_size, void* d_ws, size_t ws_size, hipStream_t stream) {
    static int grid = 0;
    if (grid == 0) {
        int dev = 0, cus = 0, per_cu = 0;
        if (hipGetDevice(&dev) != hipSuccess || hipDeviceGetAttribute(&cus, hipDeviceAttributeMultiprocessorCount, dev) != hipSuccess) { fprintf(stderr, "kernel_launch: device query failed\n"); grid = -1; return; }
        if (hipFuncSetAttribute((const void*)mk_fwd, hipFuncAttributeMaxDynamicSharedMemorySize, LDS_BYTES) != hipSuccess) { fprintf(stderr, "kernel_launch: hipFuncSetAttribute failed\n"); grid = -1; return; }
        if (hipOccupancyMaxActiveBlocksPerMultiprocessor(&per_cu, (const void*)mk_fwd, 512, LDS_BYTES) != hipSuccess || per_cu < 1) { fprintf(stderr, "kernel_launch: occupancy query says %d blocks/CU\n", per_cu); grid = -1; return; }
        grid = cus;
        if (cus != 256) { fprintf(stderr, "kernel_launch: built for a 256-CU device (one 256x256 GEMM unit per workgroup in the fused-norm phases), got %d CUs\n", cus); grid = -1; return; }
        if (n_in != 28 || ws_size < 252 * MiB) { fprintf(stderr, "kernel_launch: unexpected n_in %d / ws %zu\n", n_in, ws_size); grid = -1; return; }
    }
    if (grid < 0) return;
    if (hipMemsetAsync(d_ws, 0, CTL_ZERO_BYTES, stream) != hipSuccess) { fprintf(stderr, "kernel_launch: memset failed\n"); return; }
    Args a{};
    for (int i = 0; i < 28; ++i) a.in[i] = (const float*)d_in[i];
    a.out = (float*)d_out; a.ws = (unsigned char*)d_ws;
#ifndef PROBE_HI
#define PROBE_HI 0
#endif
#if PROBE_HI > 0
    a.ph_lo = 0; a.ph_hi = PROBE_HI;
    hipLaunchKernelGGL(mk_fwd, dim3(grid), dim3(512), LDS_BYTES, stream, a);
    (void)hipMemsetAsync(d_ws, 0, CTL_ZERO_BYTES, stream);
#endif
    a.ph_lo = 0; a.ph_hi = NPHASE;
    hipLaunchKernelGGL(mk_fwd, dim3(grid), dim3(512), LDS_BYTES, stream, a);
    const hipError_t e = hipPeekAtLastError();
    if (e != hipSuccess) fprintf(stderr, "kernel_launch: launch failed: %s (grid %d)\n", hipGetErrorString(e), grid);
}
```
